# Optimizing an MI355X kernel written in HIP

```python
import math
import jax, jax.numpy as jnp
from jax import lax
import numpy as np

D_MODEL = 2048
BATCH = 4
SEQ = 4096
DEPTH = 4

N_MIXERS = 3
HEAD_DIM = 128
N_HEADS = D_MODEL // HEAD_DIM
ROPE_THETA = 10000.0
D_FF = 4 * D_MODEL
EPS = 1e-6
SB_Q_BLOCK = 128
S5_GROUP = 16
S5_GROUPS = D_MODEL // S5_GROUP
S5_STATE = 64
S5_CHUNK = 128
S5_DT_MIN = 0.001
S5_DT_MAX = 0.1
IDX_HEADS = 16
IDX_DIM = 64
DSA_TOPK_MAX = 256
DSA_Q_BLOCK = 32
DSA_IN = 3 * D_MODEL + IDX_HEADS * IDX_DIM + IDX_DIM + IDX_HEADS

kernel_name = "hybrid_sb_s5_dsa_trunk"


def rmsnorm(x, g):
    xf = x.astype(jnp.float32)
    y = xf * lax.rsqrt(jnp.mean(xf * xf, axis=-1, keepdims=True) + EPS)
    return (y * g.astype(jnp.float32)).astype(x.dtype)


def rope(x, positions):
    d = x.shape[-1]
    inv_freq = ROPE_THETA ** (-jnp.arange(0, d, 2, dtype=jnp.float32) / d)
    ang = positions.astype(jnp.float32)[..., None] * inv_freq
    cos = jnp.cos(ang)[:, :, None, :]
    sin = jnp.sin(ang)[:, :, None, :]
    xf = x.astype(jnp.float32)
    x1, x2 = xf[..., : d // 2], xf[..., d // 2:]
    return jnp.concatenate([x1 * cos - x2 * sin, x2 * cos + x1 * sin], axis=-1).astype(x.dtype)


def modulate(h, shift, scale):
    return h * (1 + scale[:, None, :]) + shift[:, None, :]


def sq_relu_mlp(h, w1, w2):
    a = jax.nn.relu(h @ w1)
    return (a * a) @ w2


def stick_breaking_mixer(h, w_in, q_gain, k_gain, w_out):
    B, S, _ = h.shape
    q, k, v = jnp.split(h @ w_in, 3, axis=-1)
    q = rmsnorm(q.reshape(B, S, N_HEADS, HEAD_DIM), q_gain)
    k = rmsnorm(k.reshape(B, S, N_HEADS, HEAD_DIM), k_gain)
    v = v.reshape(B, S, N_HEADS, HEAD_DIM)
    nb = S // SB_Q_BLOCK
    qb = q.reshape(B, nb, SB_Q_BLOCK, N_HEADS, HEAD_DIM).transpose(1, 0, 3, 2, 4)
    kpos = jnp.arange(S)
    scale = HEAD_DIM ** -0.5

    def block(args):
        qblk, start = args
        qpos = start + jnp.arange(SB_Q_BLOCK)
        z = jnp.einsum('bhtd,bshd->bhts', qblk, k, preferred_element_type=jnp.float32) * scale
        causal = kpos[None, :] < qpos[:, None]
        log_not = jnp.where(causal, jax.nn.log_sigmoid(-z), 0.0)
        later = lax.cumsum(log_not, axis=3, reverse=True) - log_not
        w = jnp.where(causal, jnp.exp(jax.nn.log_sigmoid(z) + later), 0.0)
        return jnp.einsum('bhts,bshd->bthd', w.astype(v.dtype), v)

    starts = jnp.arange(nb) * SB_Q_BLOCK
    o = lax.map(block, (qb, starts))
    o = o.transpose(1, 0, 2, 3, 4).reshape(B, S, D_MODEL)
    return o @ w_out


def s5_mixer(h, w_in, lam_re, lam_im, log_dt, b_re, b_im, c_re, c_im, d_skip, w_glu):
    B, S, _ = h.shape
    u = h @ w_in
    ug = u.astype(jnp.float32).reshape(B, S, S5_GROUPS, S5_GROUP)
    dt = jnp.exp(log_dt.astype(jnp.float32))[:, None]
    lr = lam_re.astype(jnp.float32)
    li = lam_im.astype(jnp.float32)
    mag = jnp.exp(lr * dt)
    ar = mag * jnp.cos(li * dt)
    ai = mag * jnp.sin(li * dt)
    den = lr * lr + li * li
    fr = ((ar - 1.0) * lr + ai * li) / den
    fi = (ai * lr - (ar - 1.0) * li) / den
    br_ = b_re.astype(jnp.float32)
    bi_ = b_im.astype(jnp.float32)
    bbr = fr[..., None] * br_ - fi[..., None] * bi_
    bbi = fr[..., None] * bi_ + fi[..., None] * br_
    cr = c_re.astype(jnp.float32)
    ci = c_im.astype(jnp.float32)

    def combine(e1, e2):
        a1r, a1i, b1r, b1i = e1
        a2r, a2i, b2r, b2i = e2
        return (a1r * a2r - a1i * a2i, a1r * a2i + a1i * a2r,
                a2r * b1r - a2i * b1i + b2r, a2r * b1i + a2i * b1r + b2i)

    nc = S // S5_CHUNK
    uc = ug.reshape(B, nc, S5_CHUNK, S5_GROUPS, S5_GROUP).transpose(1, 0, 2, 3, 4)

    def chunk_step(carry, u_chunk):
        hr0, hi0 = carry
        bur = jnp.einsum('btgc,gpc->btgp', u_chunk, bbr)
        bui = jnp.einsum('btgc,gpc->btgp', u_chunk, bbi)
        a_r = jnp.broadcast_to(ar, bur.shape)
        a_i = jnp.broadcast_to(ai, bur.shape)
        pr, pi, sr, si = lax.associative_scan(combine, (a_r, a_i, bur, bui), axis=1)
        hr = sr + pr * hr0[:, None] - pi * hi0[:, None]
        hi = si + pr * hi0[:, None] + pi * hr0[:, None]
        y = jnp.einsum('btgp,gcp->btgc', hr, cr) - jnp.einsum('btgp,gcp->btgc', hi, ci)
        return (hr[:, -1], hi[:, -1]), y

    h0 = jnp.zeros((B, S5_GROUPS, S5_STATE), jnp.float32)
    _, ys = lax.scan(chunk_step, (h0, h0), uc)
    y = ys.transpose(1, 0, 2, 3, 4).reshape(B, S, D_MODEL)
    y = y + d_skip.astype(jnp.float32) * u.astype(jnp.float32)
    z = jax.nn.gelu(y).astype(h.dtype)
    a, g = jnp.split(z @ w_glu, 2, axis=-1)
    return a * jax.nn.sigmoid(g)


def dsa_mixer(h, positions, w_in, q_gain, k_gain, w_out):
    B, S, _ = h.shape
    D = D_MODEL
    cuts = [D, 2 * D, 3 * D, 3 * D + IDX_HEADS * IDX_DIM, 3 * D + IDX_HEADS * IDX_DIM + IDX_DIM]
    q, k, v, qi, ki, wi = jnp.split(h @ w_in, cuts, axis=-1)
    q = rope(rmsnorm(q.reshape(B, S, N_HEADS, HEAD_DIM), q_gain), positions)
    k = rope(rmsnorm(k.reshape(B, S, N_HEADS, HEAD_DIM), k_gain), positions)
    v = v.reshape(B, S, N_HEADS, HEAD_DIM)
    qi = rope(qi.reshape(B, S, IDX_HEADS, IDX_DIM), positions)
    ki = rope(ki.reshape(B, S, 1, IDX_DIM), positions)[:, :, 0]
    wi = wi * IDX_HEADS ** -0.5
    topk = min(DSA_TOPK_MAX, S // 4)
    nb = S // DSA_Q_BLOCK
    qb = q.reshape(B, nb, DSA_Q_BLOCK, N_HEADS, HEAD_DIM).transpose(1, 0, 2, 3, 4)
    qib = qi.reshape(B, nb, DSA_Q_BLOCK, IDX_HEADS, IDX_DIM).transpose(1, 0, 2, 3, 4)
    wib = wi.reshape(B, nb, DSA_Q_BLOCK, IDX_HEADS).transpose(1, 0, 2, 3)
    kpos = jnp.arange(S)
    gather = jax.vmap(lambda arr, idx: arr[idx])

    def block(args):
        qblk, qiblk, wiblk, start = args
        qpos = start + jnp.arange(DSA_Q_BLOCK)
        rel = jnp.einsum('bthd,bsd->bths', qiblk, ki, preferred_element_type=jnp.float32) * IDX_DIM ** -0.5
        score = jnp.einsum('bth,bths->bts', wiblk.astype(jnp.float32), jax.nn.relu(rel))
        causal = kpos[None, :] <= qpos[:, None]
        score = jnp.where(causal[None], score, -jnp.inf)
        _, idx = lax.top_k(score, topk)
        valid = idx <= qpos[None, :, None]
        k_sel = gather(k, idx)
        v_sel = gather(v, idx)
        logits = jnp.einsum('bthd,btkhd->bhtk', qblk, k_sel, preferred_element_type=jnp.float32) * HEAD_DIM ** -0.5
        logits = jnp.where(valid[:, None], logits, -jnp.inf)
        p = jax.nn.softmax(logits, axis=-1)
        return jnp.einsum('bhtk,btkhd->bthd', p.astype(v.dtype), v_sel)

    starts = jnp.arange(nb) * DSA_Q_BLOCK
    o = lax.map(block, (qb, qib, wib, starts))
    o = o.transpose(1, 0, 2, 3, 4).reshape(B, S, D_MODEL)
    return o @ w_out


def setup_inputs(seed: int = 0) -> dict:
    key = jax.random.key(seed)
    ks = iter(jax.random.split(key, 32))
    f32 = jnp.float32

    def nrm(shape, scale):
        return jax.random.normal(next(ks), shape, f32) * scale

    D = D_MODEL
    n_sb = len(range(0, DEPTH, N_MIXERS))
    n_s5 = len(range(1, DEPTH, N_MIXERS))
    n_dsa = len(range(2, DEPTH, N_MIXERS))
    G, P, Gc = S5_GROUPS, S5_STATE, S5_GROUP
    x = nrm((BATCH, SEQ, D), 1.0)
    c = nrm((BATCH, D), 1.0)
    positions = jnp.tile(jnp.arange(SEQ, dtype=jnp.int32)[None, :], (BATCH, 1))
    ln1_g = 1.0 + nrm((DEPTH, D), 0.01)
    ln2_g = 1.0 + nrm((DEPTH, D), 0.01)
    ada_w = nrm((DEPTH, D, 6 * D), 0.5 * D ** -0.5)
    ada_b = nrm((DEPTH, 6 * D), 0.02)
    mlp_w1 = nrm((DEPTH, D, D_FF), D ** -0.5)
    mlp_w2 = nrm((DEPTH, D_FF, D), D_FF ** -0.5)
    sb_w_in = nrm((n_sb, D, 3 * D), D ** -0.5)
    sb_q_gain = 1.0 + nrm((n_sb, HEAD_DIM), 0.01)
    sb_k_gain = 1.0 + nrm((n_sb, HEAD_DIM), 0.01)
    sb_w_out = nrm((n_sb, D, D), D ** -0.5)
    s5_w_in = nrm((n_s5, D, D), D ** -0.5)
    s5_lambda_re = -0.5 + nrm((n_s5, G, P), 0.01)
    s5_lambda_im = jnp.pi * jnp.arange(P, dtype=f32)[None, None, :] + nrm((n_s5, G, P), 0.01)
    s5_log_dt = jax.random.uniform(next(ks), (n_s5, G), f32, math.log(S5_DT_MIN), math.log(S5_DT_MAX))
    s5_b_re = nrm((n_s5, G, P, Gc), Gc ** -0.5)
    s5_b_im = nrm((n_s5, G, P, Gc), Gc ** -0.5)
    s5_c_re = nrm((n_s5, G, Gc, P), P ** -0.5)
    s5_c_im = nrm((n_s5, G, Gc, P), P ** -0.5)
    s5_d = nrm((n_s5, D), 1.0)
    s5_w_glu = nrm((n_s5, D, 2 * D), D ** -0.5)
    dsa_w_in = nrm((n_dsa, D, DSA_IN), D ** -0.5)
    dsa_q_gain = 1.0 + nrm((n_dsa, HEAD_DIM), 0.01)
    dsa_k_gain = 1.0 + nrm((n_dsa, HEAD_DIM), 0.01)
    dsa_w_out = nrm((n_dsa, D, D), D ** -0.5)
    return {"x": x, "c": c, "positions": positions,
            "ln1_g": ln1_g, "ln2_g": ln2_g, "ada_w": ada_w, "ada_b": ada_b,
            "mlp_w1": mlp_w1, "mlp_w2": mlp_w2,
            "sb_w_in": sb_w_in, "sb_q_gain": sb_q_gain, "sb_k_gain": sb_k_gain, "sb_w_out": sb_w_out,
            "s5_w_in": s5_w_in, "s5_lambda_re": s5_lambda_re, "s5_lambda_im": s5_lambda_im,
            "s5_log_dt": s5_log_dt, "s5_b_re": s5_b_re, "s5_b_im": s5_b_im,
            "s5_c_re": s5_c_re, "s5_c_im": s5_c_im, "s5_d": s5_d, "s5_w_glu": s5_w_glu,
            "dsa_w_in": dsa_w_in, "dsa_q_gain": dsa_q_gain, "dsa_k_gain": dsa_k_gain, "dsa_w_out": dsa_w_out}


def reference(x, c, positions, ln1_g, ln2_g, ada_w, ada_b, mlp_w1, mlp_w2,
              sb_w_in, sb_q_gain, sb_k_gain, sb_w_out,
              s5_w_in, s5_lambda_re, s5_lambda_im, s5_log_dt, s5_b_re, s5_b_im,
              s5_c_re, s5_c_im, s5_d, s5_w_glu,
              dsa_w_in, dsa_q_gain, dsa_k_gain, dsa_w_out):
    cond = jax.nn.silu(c)
    counts = [0, 0, 0]
    for i in range(DEPTH):
        mod = cond @ ada_w[i] + ada_b[i]
        sh1, sc1, g1, sh2, sc2, g2 = jnp.split(mod, 6, axis=-1)
        h = modulate(rmsnorm(x, ln1_g[i]), sh1, sc1)
        kind = i % N_MIXERS
        j = counts[kind]
        counts[kind] += 1
        if kind == 0:
            y = stick_breaking_mixer(h, sb_w_in[j], sb_q_gain[j], sb_k_gain[j], sb_w_out[j])
        elif kind == 1:
            y = s5_mixer(h, s5_w_in[j], s5_lambda_re[j], s5_lambda_im[j], s5_log_dt[j],
                         s5_b_re[j], s5_b_im[j], s5_c_re[j], s5_c_im[j], s5_d[j], s5_w_glu[j])
        else:
            y = dsa_mixer(h, positions, dsa_w_in[j], dsa_q_gain[j], dsa_k_gain[j], dsa_w_out[j])
        x = x + g1[:, None, :] * y
        h = modulate(rmsnorm(x, ln2_g[i]), sh2, sc2)
        x = x + g2[:, None, :] * sq_relu_mlp(h, mlp_w1[i], mlp_w2[i])
    return x
```

```cpp
#include <hip/hip_runtime.h>
#include <cstdio>
#include <cstdint>
#define WGM_QKV 4
#define WGM_S5U 4
#define WGM_OUT 4
#define WGM_GLU 4
#define WGM_W1 4
#define WGM_W2 4
#define REP_ATT_SB 1
#define REP_ATT_DSA 1
#define SB_STAG false
#define DSA_VARIANT 0
#define REP_LN 1
#define REP_IDX 1
#define REP_SEL 1
#define REP_CARRY 1
#define REP_MLP 1
#define MLP_VARIANT 1
#define REP_W1 1
#define REP_W2 1
#define REP_MOD 1
#define REP_TR 1
#define REP_PRO 1
#define REP_S5PRE 1
#define REP_QKV 1
#define EPI_NULL 0
#define REP_S5A 1
#define REP_S5B 1
#define REP_S5U 1
#define REP_OUT 1
namespace pg8 {
#define PG8_LAS __attribute__((address_space(3)))
typedef unsigned short bf16_t;
typedef short bf16x8 __attribute__((ext_vector_type(8)));
typedef float f32x4 __attribute__((ext_vector_type(4)));
typedef unsigned u32x4 __attribute__((ext_vector_type(4)));
constexpr int BM = 256, BK = 64, HALF = 128, HTB = HALF * BK * 2  , STAGE_BYTES = 8 * HTB, NXCD = 8, WGM = 4;

__host__ __device__ __forceinline__ int lds_byte(int r, int c) { const int st = (r >> 4) * 2 + (c >> 5), rr = r & 15, cc = c & 31, ob = rr * 64 + cc * 2; return st * 1024 + (ob ^ (((ob >> 9) & 1) << 5)); }
__host__ __device__ __forceinline__ void stage_rc(int b, int& R, int& C) { const int st = b / 1024, sb = b % 1024, swz = sb ^ (((sb >> 9) & 1) << 5); R = (st >> 1) * 16 + swz / 64; C = (st & 1) * 32 + (swz % 64) / 2; }
__host__ __device__ __forceinline__ int perm32(int rho) { const int n = rho >> 4, i = rho & 15; return 8 * (i >> 2) + 4 * n + (i & 3); }

struct Unit { int pm, pn; };
struct Gemm { const bf16_t* A; const bf16_t* Bt; int M, N, K; int lda, ldb; };

struct StaticOrder {
    int nM, nN, nwg, G, c, wgm;
    __host__ __device__ void init(int M, int N, int G_, int c_, int wgm_ = WGM) { nM = M / BM; nN = N / BM; nwg = nM * nN; G = G_; c = c_; wgm = wgm_; }
    __host__ __device__ bool next(int i, Unit& u) const {
        const long L = (long)i * G + c; if (L >= nwg) return false;
        int wgid = (int)L; { const int q = nwg / NXCD, r = nwg % NXCD, xcd = wgid % NXCD, off = wgid / NXCD; wgid = (xcd < r ? xcd * (q + 1) : r * (q + 1) + (xcd - r) * q) + off; }
        const int nig = wgm * nN, gid = wgid / nig, fm = gid * wgm, gsz = (nM - fm) < wgm ? (nM - fm) : wgm;
        u.pm = fm + ((wgid % nig) % gsz); u.pn = (wgid % nig) / gsz; return true;
    }
    __device__ __forceinline__ void a_ready(const Unit&) const {}
    __device__ __forceinline__ void done(const Unit&) const {}
};
__device__ __forceinline__ unsigned cvt_pk_bf16(float lo, float hi) { unsigned r; asm volatile("v_cvt_pk_bf16_f32 %0, %1, %2" : "=v"(r) : "v"(lo), "v"(hi)); return r; }
typedef float f32x2 __attribute__((ext_vector_type(2)));
typedef unsigned u32x2 __attribute__((ext_vector_type(2)));
struct EpiF32 {
    static constexpr bool PERM = false, AFTER_DRAIN = false;
    float* C; int ldc;
    __device__ __forceinline__ void operator()(const f32x4 (&acc)[2][2][4][2], const Unit& u, int wr, int wc, int fr, int fq) const {
        const int row0 = u.pm * BM + wr * 64 + fr, col0 = u.pn * BM + wc * 32 + 4 * fq;
#pragma unroll
        for (int ai = 0; ai < 2; ++ai)
#pragma unroll
            for (int m = 0; m < 4; ++m) { float* rowp = C + (size_t)(row0 + ai * HALF + m * 16) * ldc + col0;
#pragma unroll
                for (int bj = 0; bj < 2; ++bj)
#pragma unroll
                    for (int n = 0; n < 2; ++n) *(f32x4*)(rowp + bj * HALF + n * 16) = acc[ai][bj][m][n]; }
    }
};
typedef _Float16 h16x8 __attribute__((ext_vector_type(8)));
typedef _Float16 h16x4 __attribute__((ext_vector_type(4)));
struct EpiRes {
    static constexpr bool PERM = true, AFTER_DRAIN = false;
    const void* base; void* out; const float* gate; int gpitch; int in_f32, out_f32;
    __device__ __forceinline__ void operator()(const f32x4 (&acc)[2][2][4][2], const Unit& u, int wr, int wc, int fr, int fq) const {
        const int row0 = u.pm * BM + wr * 64 + fr, col0 = u.pn * BM + wc * 32 + 8 * fq;
        const float* gp = gate + (size_t)(u.pm >> 4) * gpitch + col0;
        f32x4 gv[2][2];
#pragma unroll
        for (int bj = 0; bj < 2; ++bj)
#pragma unroll
            for (int n = 0; n < 2; ++n) gv[bj][n] = *(const f32x4*)(gp + bj * HALF + n * 4);
#pragma unroll
        for (int ai = 0; ai < 2; ++ai)
#pragma unroll
            for (int m = 0; m < 4; ++m) { const size_t off = (size_t)(row0 + ai * HALF + m * 16) * 2048 + col0;
#pragma unroll
                for (int bj = 0; bj < 2; ++bj) { f32x4 b0, b1;
                    if (in_f32) { b0 = *(const f32x4*)((const float*)base + off + bj * HALF); b1 = *(const f32x4*)((const float*)base + off + bj * HALF + 4); }
                    else { const h16x8 hv = *(const h16x8*)((const _Float16*)base + off + bj * HALF);
                        b0 = (f32x4){(float)hv[0], (float)hv[1], (float)hv[2], (float)hv[3]}; b1 = (f32x4){(float)hv[4], (float)hv[5], (float)hv[6], (float)hv[7]}; }
                    const f32x4 r0 = b0 + gv[bj][0] * acc[ai][bj][m][0], r1 = b1 + gv[bj][1] * acc[ai][bj][m][1];
                    if (out_f32) { *(f32x4*)((float*)out + off + bj * HALF) = r0; *(f32x4*)((float*)out + off + bj * HALF + 4) = r1; }
                    else { h16x8 o; o[0] = (_Float16)r0[0]; o[1] = (_Float16)r0[1]; o[2] = (_Float16)r0[2]; o[3] = (_Float16)r0[3]; o[4] = (_Float16)r1[0]; o[5] = (_Float16)r1[1]; o[6] = (_Float16)r1[2]; o[7] = (_Float16)r1[3];
                        *(h16x8*)((_Float16*)out + off + bj * HALF) = o; } }
                if (m == 3) asm volatile("" ::: "memory"); }
    }
};
struct EpiRelu2 {
    static constexpr bool PERM = true, AFTER_DRAIN = false;
    bf16_t* O; int ldc; int skip = 0;
    __device__ __forceinline__ void operator()(const f32x4 (&acc)[2][2][4][2], const Unit& u, int wr, int wc, int fr, int fq) const {
        if (skip) return;
        const int row0 = u.pm * BM + wr * 64 + fr, col0 = u.pn * BM + wc * 32 + 8 * fq;
#pragma unroll
        for (int ai = 0; ai < 2; ++ai)
#pragma unroll
            for (int m = 0; m < 4; ++m) { bf16_t* rowp = O + (size_t)(row0 + ai * HALF + m * 16) * ldc + col0;
#pragma unroll
                for (int bj = 0; bj < 2; ++bj) { f32x4 v0 = acc[ai][bj][m][0], v1 = acc[ai][bj][m][1];
#pragma unroll
                    for (int j = 0; j < 4; ++j) { const float a = fmaxf(v0[j], 0.f), b = fmaxf(v1[j], 0.f); v0[j] = a * a; v1[j] = b * b; }
                    u32x4 w; w.x = cvt_pk_bf16(v0[0], v0[1]); w.y = cvt_pk_bf16(v0[2], v0[3]); w.z = cvt_pk_bf16(v1[0], v1[1]); w.w = cvt_pk_bf16(v1[2], v1[3]);
                    *(u32x4*)(rowp + bj * HALF) = w; } }
    }
};
struct EpiBf16Plain {
    static constexpr bool PERM = true, AFTER_DRAIN = false;
    bf16_t* O; int ldc;
    __device__ __forceinline__ void operator()(const f32x4 (&acc)[2][2][4][2], const Unit& u, int wr, int wc, int fr, int fq) const {
        const int row0 = u.pm * BM + wr * 64 + fr, col0 = u.pn * BM + wc * 32 + 8 * fq;
#pragma unroll
        for (int ai = 0; ai < 2; ++ai)
#pragma unroll
            for (int m = 0; m < 4; ++m) { bf16_t* rowp = O + (size_t)(row0 + ai * HALF + m * 16) * ldc + col0;
#pragma unroll
                for (int bj = 0; bj < 2; ++bj) { const f32x4 v0 = acc[ai][bj][m][0], v1 = acc[ai][bj][m][1];
                    u32x4 w; w.x = cvt_pk_bf16(v0[0], v0[1]); w.y = cvt_pk_bf16(v0[2], v0[3]); w.z = cvt_pk_bf16(v1[0], v1[1]); w.w = cvt_pk_bf16(v1[2], v1[3]);
                    *(u32x4*)(rowp + bj * HALF) = w; } }
    }
};
struct EpiGluRes {
    static constexpr bool PERM = false, AFTER_DRAIN = false;
    const _Float16* base; _Float16* out; const float* gate; int gpitch;
    __device__ __forceinline__ void operator()(const f32x4 (&acc)[2][2][4][2], const Unit& u, int wr, int wc, int fr, int fq) const {
        const int row0 = u.pm * BM + wr * 64 + fr, col0 = u.pn * HALF + wc * 32 + 4 * fq;
        const float* gp = gate + (size_t)(u.pm >> 4) * gpitch + col0;
        f32x4 gv[2];
#pragma unroll
        for (int n = 0; n < 2; ++n) gv[n] = *(const f32x4*)(gp + n * 16);
#pragma unroll
        for (int ai = 0; ai < 2; ++ai)
#pragma unroll
            for (int m = 0; m < 4; ++m) { const size_t off = (size_t)(row0 + ai * HALF + m * 16) * 2048 + col0;
#pragma unroll
                for (int n = 0; n < 2; ++n) { const h16x4 hv = *(const h16x4*)(base + off + n * 16); const f32x4 bs = {(float)hv[0], (float)hv[1], (float)hv[2], (float)hv[3]};
                    const f32x4 a = acc[ai][0][m][n], g = acc[ai][1][m][n]; f32x4 y;
#pragma unroll
                    for (int j = 0; j < 4; ++j) y[j] = a[j] * __builtin_amdgcn_rcpf(1.0f + __builtin_amdgcn_exp2f(-1.4426950408889634f * g[j]));
                    const f32x4 r = bs + gv[n] * y; h16x4 o; o[0] = (_Float16)r[0]; o[1] = (_Float16)r[1]; o[2] = (_Float16)r[2]; o[3] = (_Float16)r[3];
                    *(h16x4*)(out + off + n * 16) = o; }
                if (m == 3) asm volatile("" ::: "memory"); }
    }
};
struct GroupOrder {
    int G, c;
    __device__ __forceinline__ bool next(int i, Unit& u) const { const int L = i * G + c; if (L >= 512) return false; u.pm = L; u.pn = L >> 2; return true; }
    __device__ __forceinline__ void a_ready(const Unit&) const {}
    __device__ __forceinline__ void done(const Unit&) const {}
};
struct EpiS5U {
    static constexpr bool PERM = true, AFTER_DRAIN = false;
    bf16_t* AG;
    __device__ __forceinline__ void operator()(const f32x4 (&acc)[2][2][4][2], const Unit& u, int wr, int wc, int fr, int fq) const {
        const int row0 = u.pm * BM + wr * 64 + fr, col0 = u.pn * BM + wc * 32 + 8 * fq;
#pragma unroll
        for (int ai = 0; ai < 2; ++ai)
#pragma unroll
            for (int m = 0; m < 4; ++m) { const int row = row0 + ai * HALF + m * 16, rb = (row >> 12) * 256 + ((row & 4095) >> 4), tl = row & 15;
#pragma unroll
                for (int bj = 0; bj < 2; ++bj) { const int col = col0 + bj * HALF, g = col >> 4, c0 = col & 15; const f32x4 v0 = acc[ai][bj][m][0], v1 = acc[ai][bj][m][1];
                    u32x4 w; w.x = cvt_pk_bf16(v0[0], v0[1]); w.y = cvt_pk_bf16(v0[2], v0[3]); w.z = cvt_pk_bf16(v1[0], v1[1]); w.w = cvt_pk_bf16(v1[2], v1[3]);
                    *(u32x4*)(AG + ((size_t)(g * 1024 + rb) * 384 + tl * 16 + c0)) = w; } }
    }
};
struct EpiS5E {
    static constexpr bool PERM = false, AFTER_DRAIN = false;
    float* E;
    __device__ __forceinline__ void operator()(const f32x4 (&acc)[2][2][4][2], const Unit& u, int wr, int wc, int fr, int fq) const {
        const int row0 = u.pm * BM + wr * 64 + fr, col0 = wc * 32 + 4 * fq;
#pragma unroll
        for (int ai = 0; ai < 2; ++ai)
#pragma unroll
            for (int m = 0; m < 4; ++m) { float* rowp = E + (size_t)(row0 + ai * HALF + m * 16) * 128 + col0;
#pragma unroll
                for (int n = 0; n < 2; ++n) *(f32x4*)(rowp + n * 16) = acc[ai][0][m][n]; }
    }
};
struct EpiS5Out {
    static constexpr bool PERM = true, AFTER_DRAIN = false;
    __amdgpu_buffer_rsrc_t rAG, rZG, rD;
    __device__ __forceinline__ void operator()(const f32x4 (&acc)[2][2][4][2], const Unit& u, int wr, int wc, int, int) const {
        int ln; asm volatile("v_mbcnt_lo_u32_b32 %0, -1, 0\n\tv_mbcnt_hi_u32_b32 %0, -1, %0" : "=v"(ln));
        const int fr = ln & 15, fq = ln >> 4;
        const int col0 = wc * 32 + 8 * fq;
        const unsigned rowb = (unsigned)(u.pm * BM + wr * 64 + fr);
        const unsigned dof = (unsigned)(u.pn * 16 + 8 * (fq & 1)) * 4u;
        const f32x4 d0 = __builtin_bit_cast(f32x4, __builtin_amdgcn_raw_buffer_load_b128(rD, dof, 0, 0)), d1 = __builtin_bit_cast(f32x4, __builtin_amdgcn_raw_buffer_load_b128(rD, dof + 16u, 0, 0));
#pragma unroll
        for (int ai = 0; ai < 2; ++ai)
#pragma unroll
            for (int m = 0; m < 4; ++m) { const unsigned row = rowb + (unsigned)(ai * HALF + m * 16);
#pragma unroll
                for (int bj = 0; bj < 2; ++bj) { const int n0 = col0 + bj * HALF;
                    const u32x4 uv = __builtin_bit_cast(u32x4, __builtin_amdgcn_raw_buffer_load_b128(rAG, (row * 384u + (unsigned)n0) * 2u, 0, 0));
                    const unsigned ux = uv[0], uy = uv[1], uz = uv[2], uw = uv[3];
                    f32x4 y0 = acc[ai][bj][m][0], y1 = acc[ai][bj][m][1];
                    y0[0] += d0[0] * __builtin_bit_cast(float, ux << 16); y0[1] += d0[1] * __builtin_bit_cast(float, ux & 0xffff0000u);
                    y0[2] += d0[2] * __builtin_bit_cast(float, uy << 16); y0[3] += d0[3] * __builtin_bit_cast(float, uy & 0xffff0000u);
                    y1[0] += d1[0] * __builtin_bit_cast(float, uz << 16); y1[1] += d1[1] * __builtin_bit_cast(float, uz & 0xffff0000u);
                    y1[2] += d1[2] * __builtin_bit_cast(float, uw << 16); y1[3] += d1[3] * __builtin_bit_cast(float, uw & 0xffff0000u);
#pragma unroll
                    for (int j = 0; j < 4; ++j) {
                        { const float y = y0[j], a2 = 1.5957691216057308f * (y + 0.044715f * y * y * y); y0[j] = y * __builtin_amdgcn_rcpf(1.0f + __builtin_amdgcn_exp2f(-1.4426950408889634f * a2)); }
                        { const float y = y1[j], a2 = 1.5957691216057308f * (y + 0.044715f * y * y * y); y1[j] = y * __builtin_amdgcn_rcpf(1.0f + __builtin_amdgcn_exp2f(-1.4426950408889634f * a2)); } }
                    u32x4 w; w.x = cvt_pk_bf16(y0[0], y0[1]); w.y = cvt_pk_bf16(y0[2], y0[3]); w.z = cvt_pk_bf16(y1[0], y1[1]); w.w = cvt_pk_bf16(y1[2], y1[3]);
                    __builtin_amdgcn_raw_buffer_store_b128(w, rZG, (row * 256u + (unsigned)n0) * 2u, 0, 0); } }
    }
};
struct EpiQkv {
    static constexpr bool PERM = false, AFTER_DRAIN = false;
    bf16_t* QN; bf16_t* KN; bf16_t* VN; bf16_t* QI; bf16_t* KI; float* WI;
    const float* gq; const float* gk; const float* CS; const float* CS2; int dsa; float QS, eps;
    PG8_LAS float* P;
    int skip = 0;
    __device__ __forceinline__ static unsigned long long pk4(const f32x4 v) { return (unsigned long long)cvt_pk_bf16(v[0], v[1]) | ((unsigned long long)cvt_pk_bf16(v[2], v[3]) << 32); }
    __device__ __forceinline__ void operator()(const f32x4 (&acc)[2][2][4][2], const Unit& u, int wr, int wc, int fr, int fq) const {
        if (skip) return;
        const int row0 = u.pm * BM + wr * 64 + fr, lrow0 = wr * 64 + fr, sec = u.pn >> 3;
        if (sec < 2) {
            const int xidx = ((fr + 16 * fq) ^ 32) << 2;
#pragma unroll
            for (int ai = 0; ai < 2; ++ai)
#pragma unroll
                for (int m = 0; m < 4; ++m)
#pragma unroll
                    for (int bj = 0; bj < 2; ++bj) { const f32x4 a = acc[ai][bj][m][0], b = acc[ai][bj][m][1];
                        float ss = ((a[0] * a[0] + a[1] * a[1]) + (a[2] * a[2] + a[3] * a[3])) + ((b[0] * b[0] + b[1] * b[1]) + (b[2] * b[2] + b[3] * b[3]));
                        ss += __builtin_bit_cast(float, (unsigned)__builtin_amdgcn_ds_swizzle(__builtin_bit_cast(int, ss), (16 << 10) | 0x1F));
                        ss += __builtin_bit_cast(float, __builtin_amdgcn_ds_bpermute(xidx, __builtin_bit_cast(int, ss)));
                        if (fq == 0) P[((ai * HALF + lrow0 + m * 16) * 2 + bj) * 4 + wc] = ss; }
            asm volatile("s_waitcnt lgkmcnt(0)" ::: "memory"); __builtin_amdgcn_s_barrier(); asm volatile("" ::: "memory");
            int d0 = 16 * wc + 4 * fq; asm volatile("" : "+v"(d0));
            const float* gp = sec ? gk : gq;
            const f32x4 g0 = *(const f32x4*)(gp + d0), g1 = *(const f32x4*)(gp + 64 + d0);
            const f32x4 h0 = *(const f32x4*)(gp + 2 * d0), h1 = *(const f32x4*)(gp + 2 * d0 + 4);
            bf16_t* dst = (sec ? KN : QN) + (size_t)(u.pn & 7) * 256 + d0; const float qs = sec ? 1.0f : QS;
#pragma unroll
            for (int ai = 0; ai < 2; ++ai)
#pragma unroll
                for (int m = 0; m < 4; ++m) { const int lrow = ai * HALF + lrow0 + m * 16; const size_t row = (size_t)(row0 + ai * HALF + m * 16);
                    if (dsa) {
                        const f32x4 cs = *(const f32x4*)(CS + row * 128 + d0), sn = *(const f32x4*)(CS + row * 128 + 64 + d0);
#pragma unroll
                        for (int bj = 0; bj < 2; ++bj) { const f32x4 pp = *(const PG8_LAS f32x4*)(P + (lrow * 2 + bj) * 4);
                            const float r = qs * __builtin_amdgcn_rsqf(((pp[0] + pp[1]) + (pp[2] + pp[3])) * (1.0f / 128.0f) + eps);
                            const f32x4 y0 = acc[ai][bj][m][0] * r * g0, y1 = acc[ai][bj][m][1] * r * g1;
                            const f32x4 o0 = y0 * cs - y1 * sn, o1 = y1 * cs + y0 * sn;
                            bf16_t* dp = dst + row * 2048 + bj * 128;
                            *(unsigned long long*)dp = pk4(o0); *(unsigned long long*)(dp + 64) = pk4(o1); }
                    } else {
#pragma unroll
                        for (int bj = 0; bj < 2; ++bj) { const f32x4 pp = *(const PG8_LAS f32x4*)(P + (lrow * 2 + bj) * 4);
                            const float r = qs * __builtin_amdgcn_rsqf(((pp[0] + pp[1]) + (pp[2] + pp[3])) * (1.0f / 128.0f) + eps);
                            const f32x4 y0 = acc[ai][bj][m][0] * r * h0, y1 = acc[ai][bj][m][1] * r * h1;
                            u32x4 w; w.x = cvt_pk_bf16(y0[0], y0[1]); w.y = cvt_pk_bf16(y0[2], y0[3]); w.z = cvt_pk_bf16(y1[0], y1[1]); w.w = cvt_pk_bf16(y1[2], y1[3]);
                            *(u32x4*)(dst + d0 + row * 2048 + bj * 128) = w; }
                    } }
        } else if (sec == 2) {
            bf16_t* dst = VN + (size_t)(u.pn & 7) * 256 + 32 * wc + 8 * fq;
#pragma unroll
            for (int ai = 0; ai < 2; ++ai)
#pragma unroll
                for (int m = 0; m < 4; ++m) { const size_t row = (size_t)(row0 + ai * HALF + m * 16);
#pragma unroll
                    for (int bj = 0; bj < 2; ++bj) { const f32x4 v0 = acc[ai][bj][m][0], v1 = acc[ai][bj][m][1];
                        u32x4 w; w.x = cvt_pk_bf16(v0[0], v0[1]); w.y = cvt_pk_bf16(v0[2], v0[3]); w.z = cvt_pk_bf16(v1[0], v1[1]); w.w = cvt_pk_bf16(v1[2], v1[3]);
                        *(u32x4*)(dst + row * 2048 + bj * 128) = w; } }
        } else if (u.pn < 28) {
            const int d0 = 16 * (wc & 1) + 4 * fq;
#pragma unroll
            for (int ai = 0; ai < 2; ++ai)
#pragma unroll
                for (int m = 0; m < 4; ++m) { const size_t row = (size_t)(row0 + ai * HALF + m * 16);
                    const f32x4 cs = *(const f32x4*)(CS2 + row * 64 + d0), sn = *(const f32x4*)(CS2 + row * 64 + 32 + d0);
#pragma unroll
                    for (int bj = 0; bj < 2; ++bj) { const f32x4 y0 = acc[ai][bj][m][0], y1 = acc[ai][bj][m][1];
                        const f32x4 o0 = y0 * cs - y1 * sn, o1 = y1 * cs + y0 * sn;
                        bf16_t* dp = QI + row * 1024 + (size_t)((2 * (u.pn - 24) + bj) * 2 + (wc >> 1)) * 64 + d0;
                        *(unsigned long long*)dp = pk4(o0); *(unsigned long long*)(dp + 32) = pk4(o1); } }
        } else {
            const int d0 = 16 * (wc & 1) + 4 * fq;
#pragma unroll
            for (int ai = 0; ai < 2; ++ai)
#pragma unroll
                for (int m = 0; m < 4; ++m) { const size_t row = (size_t)(row0 + ai * HALF + m * 16);
                    if (wc < 2) { const f32x4 cs = *(const f32x4*)(CS2 + row * 64 + d0), sn = *(const f32x4*)(CS2 + row * 64 + 32 + d0);
                        const f32x4 y0 = acc[ai][0][m][0], y1 = acc[ai][0][m][1]; const f32x4 o0 = y0 * cs - y1 * sn, o1 = y1 * cs + y0 * sn;
                        bf16_t* dp = KI + row * 64 + d0; *(unsigned long long*)dp = pk4(o0); *(unsigned long long*)(dp + 32) = pk4(o1); }
                    else if (wc == 2) *(f32x4*)(WI + row * 16 + 4 * fq) = acc[ai][0][m][0] * (0.25f * 0.125f); }
        }
    }
};
template <class Epi, class Sched, bool ALIGN_EPI = false, bool SP2 = false, bool AGRP = false  >
__device__ __forceinline__ void gemm_phase(PG8_LAS unsigned char* lds, const Gemm g, const Sched& S, const Epi& E, int wid_in  ) {
    int lane_; asm volatile("v_mbcnt_lo_u32_b32 %0, -1, 0\n\tv_mbcnt_hi_u32_b32 %0, -1, %0" : "=v"(lane_));
    const int wid = wid_in, tid = wid * 64 + lane_, lane = lane_, wr = wid >> 2, wc = wid & 3, fr = lane & 15, fq = lane >> 4;
    const int K = g.K, nt = K / BK, lda = g.lda ? g.lda : K, ldb = g.ldb ? g.ldb : K;
    unsigned voffA[2], voffB[2];
#pragma unroll
    for (int i = 0; i < 2; ++i) { int R, C; stage_rc(tid * 16 + i * 8192, R, C); const int Rb = Epi::PERM ? ((R & ~31) + perm32(R & 31)) : R;
        voffA[i] = AGRP ? (unsigned)((C >> 4) * (g.M * 16) + R * 16 + (C & 15)) * 2u : (unsigned)(R * lda + C) * 2u; voffB[i] = (unsigned)(Rb * ldb + C) * 2u; }
    const size_t kstepA = AGRP ? (size_t)4 * g.M * 16 * 2 : (size_t)(BK * 2), kstepB = (size_t)(BK * 2);
    const size_t hstepA = AGRP ? (size_t)HALF * 16 * 2 : (size_t)HALF * lda * 2, hstepB = (size_t)HALF * ldb * 2;
    const size_t tstepA = 2 * hstepA, tstepB = 2 * hstepB;
    const unsigned ldsw = (unsigned)wid * 1024u;
    const int aoff = lds_byte(wr * 64 + fr, fq * 8), boff = lds_byte(wc * 32 + fr, fq * 8);
#define PG8_SA(b, h) (((b) * 2 + (h)) * HTB)
#define PG8_SB(b, h) ((4 + (b) * 2 + (h)) * HTB)
#define PG8_STAGE(bufoff, gbase, voff) do { _Pragma("unroll") for (int _i = 0; _i < 2; ++_i) \
        __builtin_amdgcn_global_load_lds((const unsigned*)((const char*)(gbase) + (voff)[_i]), (PG8_LAS unsigned*)(lds + (bufoff) + ldsw + _i * 8192), 16, 0, 0); } while (0)
#define PG8_LDA(dst, b, h) do { _Pragma("unroll") for (int m = 0; m < 4; ++m) _Pragma("unroll") for (int k = 0; k < 2; ++k) dst[m][k] = *(const PG8_LAS bf16x8*)(lds + PG8_SA(b, h) + aoff + m * 2048 + k * 1024); } while (0)
#define PG8_LDB(dst, b, h) do { _Pragma("unroll") for (int n = 0; n < 2; ++n) _Pragma("unroll") for (int k = 0; k < 2; ++k) dst[n][k] = *(const PG8_LAS bf16x8*)(lds + PG8_SB(b, h) + boff + n * 2048 + k * 1024); } while (0)
#define PG8_MMA(ai, bj, At, Bt) do { __builtin_amdgcn_s_setprio(1); _Pragma("unroll") for (int m = 0; m < 4; ++m) _Pragma("unroll") for (int n = 0; n < 2; ++n) _Pragma("unroll") for (int k = 0; k < 2; ++k) \
        acc[ai][bj][m][n] = __builtin_amdgcn_mfma_f32_16x16x32_bf16(Bt[n][k], At[m][k], acc[ai][bj][m][n], 0, 0, 0); __builtin_amdgcn_s_setprio(0); } while (0)
#define PG8_WAIT_V(n) asm volatile("s_waitcnt vmcnt(" #n ")" ::: "memory")
#define PG8_WAIT_L(n) asm volatile("s_waitcnt lgkmcnt(" #n ")" ::: "memory")
#define PG8_BAR __builtin_amdgcn_s_barrier()
#define PG8_SCHED __builtin_amdgcn_sched_barrier(0)
    Unit cur, nxt; int ui = 0;
    if (!S.next(0, cur)) return;
    f32x4 acc[2][2][4][2];
#pragma unroll
    for (int a = 0; a < 2; ++a)
#pragma unroll
        for (int b = 0; b < 2; ++b)
#pragma unroll
            for (int m = 0; m < 4; ++m)
#pragma unroll
                for (int n = 0; n < 2; ++n) acc[a][b][m][n] = (f32x4){0.f, 0.f, 0.f, 0.f};
    bf16x8 At[4][2], B0[2][2], B1[2][2];
    const char* cA = (const char*)g.A + (size_t)cur.pm * tstepA; const char* cB = (const char*)g.Bt + (size_t)cur.pn * tstepB;
    S.a_ready(cur);
    if constexpr (SP2) {
        PG8_STAGE(PG8_SB(0, 0), cB, voffB); PG8_STAGE(PG8_SB(0, 1), cB + hstepB, voffB); PG8_STAGE(PG8_SA(0, 0), cA, voffA); PG8_STAGE(PG8_SA(0, 1), cA + hstepA, voffA);
        if (wr == 1) PG8_BAR;
        PG8_WAIT_V(2); PG8_BAR;
        PG8_STAGE(PG8_SB(1, 0), cB + kstepB, voffB); PG8_STAGE(PG8_SA(1, 0), cA + kstepA, voffA); PG8_STAGE(PG8_SB(1, 1), cB + hstepB + kstepB, voffB);
        PG8_WAIT_V(6); PG8_BAR;
    } else {
        PG8_STAGE(PG8_SB(0, 0), cB, voffB); PG8_STAGE(PG8_SA(0, 0), cA, voffA); PG8_STAGE(PG8_SB(0, 1), cB + hstepB, voffB); PG8_STAGE(PG8_SA(0, 1), cA + hstepA, voffA);
        if (wr == 1) PG8_BAR;
        PG8_WAIT_V(4); PG8_BAR;
        PG8_STAGE(PG8_SB(1, 0), cB + kstepB, voffB); PG8_STAGE(PG8_SA(1, 0), cA + kstepA, voffA); PG8_STAGE(PG8_SB(1, 1), cB + hstepB + kstepB, voffB);
        PG8_WAIT_V(6); PG8_BAR;
    }
    for (;;) {
        const bool has_next = S.next(ui + 1, nxt);
        const char* nA = has_next ? (const char*)g.A + (size_t)nxt.pm * tstepA : cA; const char* nB = has_next ? (const char*)g.Bt + (size_t)nxt.pn * tstepB : cB;
        for (int t = 0; t < nt; t += 2) {
            const bool last = (t == nt - 2);
            const char* a1 = cA + (size_t)(t + 1) * kstepA;
            const char* a2 = last ? nA : cA + (size_t)(t + 2) * kstepA; const char* b2 = last ? nB : cB + (size_t)(t + 2) * kstepB;
            const char* a3 = a2 + kstepA; const char* b3 = b2 + kstepB;
            if (last && has_next) S.a_ready(nxt);
            if constexpr (SP2) {
            PG8_LDB(B0, 0, 0); PG8_LDB(B1, 0, 1); PG8_SCHED; PG8_LDA(At, 0, 0); PG8_STAGE(PG8_SA(1, 1), a1 + hstepA, voffA);
            PG8_WAIT_V(8); PG8_WAIT_L(0); PG8_BAR; PG8_MMA(0, 0, At, B0); PG8_MMA(0, 1, At, B1); PG8_BAR; PG8_SCHED;
            PG8_LDA(At, 0, 1); PG8_STAGE(PG8_SB(0, 0), b2, voffB); PG8_STAGE(PG8_SB(0, 1), b2 + hstepB, voffB); PG8_STAGE(PG8_SA(0, 0), a2, voffA);
            PG8_WAIT_V(8); PG8_WAIT_L(0); PG8_BAR; PG8_MMA(1, 0, At, B0); PG8_MMA(1, 1, At, B1); PG8_BAR; PG8_SCHED;
            PG8_LDB(B0, 1, 0); PG8_LDB(B1, 1, 1); PG8_SCHED; PG8_LDA(At, 1, 0); PG8_STAGE(PG8_SA(0, 1), a2 + hstepA, voffA);
            PG8_WAIT_V(8); PG8_WAIT_L(0); PG8_BAR; PG8_MMA(0, 0, At, B0); PG8_MMA(0, 1, At, B1); PG8_BAR; PG8_SCHED;
            PG8_LDA(At, 1, 1); PG8_STAGE(PG8_SB(1, 0), b3, voffB); PG8_STAGE(PG8_SB(1, 1), b3 + hstepB, voffB); PG8_STAGE(PG8_SA(1, 0), a3, voffA);
            PG8_WAIT_V(8); PG8_WAIT_L(0); PG8_BAR; PG8_MMA(1, 0, At, B0); PG8_MMA(1, 1, At, B1); PG8_BAR; PG8_SCHED;
            } else {
            PG8_LDB(B0, 0, 0); PG8_SCHED; PG8_LDA(At, 0, 0); PG8_STAGE(PG8_SA(1, 1), a1 + hstepA, voffA);
            PG8_WAIT_L(8); PG8_BAR; PG8_WAIT_L(0); PG8_MMA(0, 0, At, B0); PG8_BAR; PG8_SCHED;
            PG8_LDB(B1, 0, 1); PG8_STAGE(PG8_SB(0, 0), b2, voffB);
            PG8_BAR; PG8_WAIT_L(0); PG8_MMA(0, 1, At, B1); PG8_BAR;
            PG8_LDA(At, 0, 1); PG8_STAGE(PG8_SA(0, 0), a2, voffA);
            PG8_BAR; PG8_WAIT_L(0); PG8_MMA(1, 0, At, B0); PG8_BAR; PG8_SCHED;
            PG8_STAGE(PG8_SB(0, 1), b2 + hstepB, voffB);
            PG8_WAIT_V(6); PG8_BAR; PG8_MMA(1, 1, At, B1); PG8_BAR;
            PG8_LDB(B0, 1, 0); PG8_SCHED; PG8_LDA(At, 1, 0); PG8_STAGE(PG8_SA(0, 1), a2 + hstepA, voffA);
            PG8_WAIT_L(8); PG8_BAR; PG8_WAIT_L(0); PG8_MMA(0, 0, At, B0); PG8_BAR; PG8_SCHED;
            PG8_LDB(B1, 1, 1); PG8_STAGE(PG8_SB(1, 0), b3, voffB);
            PG8_BAR; PG8_WAIT_L(0); PG8_MMA(0, 1, At, B1); PG8_BAR;
            PG8_LDA(At, 1, 1); PG8_STAGE(PG8_SA(1, 0), a3, voffA);
            PG8_BAR; PG8_WAIT_L(0); PG8_MMA(1, 0, At, B0); PG8_BAR; PG8_SCHED;
            PG8_STAGE(PG8_SB(1, 1), b3 + hstepB, voffB);
            PG8_WAIT_V(6); PG8_BAR; PG8_MMA(1, 1, At, B1); PG8_BAR;
            }
        }
        if constexpr (ALIGN_EPI) { if (wr == 0) PG8_BAR; }
        if constexpr (!Epi::AFTER_DRAIN) { E(acc, cur, wr, wc, fr, fq); S.done(cur); }
        if (!has_next) break;
#pragma unroll
        for (int a = 0; a < 2; ++a)
#pragma unroll
            for (int b = 0; b < 2; ++b)
#pragma unroll
                for (int m = 0; m < 4; ++m)
#pragma unroll
                    for (int n = 0; n < 2; ++n) acc[a][b][m][n] = (f32x4){0.f, 0.f, 0.f, 0.f};
        cur = nxt; cA = nA; cB = nB; ++ui;
        if constexpr (ALIGN_EPI) { if (wr == 1) PG8_BAR; }
    }
    PG8_WAIT_V(0);
    if constexpr (!ALIGN_EPI) { if (wr == 0) PG8_BAR; }
    PG8_BAR;
    if constexpr (Epi::AFTER_DRAIN) { E.fused(acc, cur, wr, wc, fr, fq, lds, wid, lane); S.done(cur); }
#undef PG8_SA
#undef PG8_SB
#undef PG8_STAGE
#undef PG8_LDA
#undef PG8_LDB
#undef PG8_MMA
#undef PG8_WAIT_V
#undef PG8_WAIT_L
#undef PG8_BAR
#undef PG8_SCHED
}
}
constexpr int NB = 4, S = 4096, D = 2048, M = NB * S, FF = 8192, NH = 16, HD = 128, NL = 4;
constexpr int G5 = 128, P5 = 64, C5 = 16;
constexpr int DSA_N = 7248, DSA_NP = 7424, TOPK = 256;
constexpr float EPS = 1e-6f;
constexpr float QSCALE = 0.08838834764831845f * 1.4426950408889634f;
constexpr int NWAVES = 8;

constexpr size_t MiB = 1u << 20;
constexpr size_t WS_CTL = 0, CTL_ZERO_BYTES = 1 * MiB;
constexpr size_t WS_MOD = 2 * MiB;
constexpr size_t WS_S5C = 3 * MiB;
constexpr size_t WS_W1T = 8 * MiB;
constexpr size_t WS_W2T = WS_W1T + 128 * MiB;
constexpr size_t WS_SBIN = WS_W2T + 128 * MiB;
constexpr size_t WS_SBOUT = WS_SBIN + 48 * MiB;
constexpr size_t WS_S5IN = WS_SBOUT + 16 * MiB;
constexpr size_t WS_S5GLU = WS_S5IN + 8 * MiB;
constexpr size_t WS_DSAIN = WS_S5GLU + 16 * MiB;
constexpr size_t WS_DSAOUT = WS_DSAIN + 29 * MiB;
constexpr size_t WS_H = WS_DSAOUT + 8 * MiB + 3 * MiB;
constexpr size_t WS_BIG = WS_H + 64 * MiB;
constexpr size_t WS_QN = WS_BIG + 464 * MiB, WS_KN = WS_QN + 64 * MiB, WS_VN = WS_KN + 64 * MiB, WS_O = WS_VN + 64 * MiB;
constexpr size_t WS_QI = WS_O + 64 * MiB;
constexpr size_t WS_CS = WS_QI + 32 * MiB, WS_CS2 = WS_QI + 40 * MiB;
constexpr size_t WS_KI = WS_QI + 64 * MiB;
constexpr size_t WS_WI = WS_KI + 4 * MiB;
constexpr size_t WS_BITS = WS_WI + 1 * MiB;
constexpr size_t WS_B1 = WS_BITS + 8 * MiB;
constexpr size_t WS_B3 = WS_B1 + 16 * MiB;
constexpr size_t WS_END = WS_B3 + 24 * MiB;
constexpr size_t WS_AG = WS_BIG;
constexpr size_t WS_XH = WS_BIG + 384 * MiB;
constexpr size_t WS_E = WS_BIG + 96 * MiB;
static_assert((size_t)DSA_NP * D * 2 == 29 * MiB && (size_t)M * DSA_NP * 4 == 464 * MiB, "ws map");
constexpr int CW_TMO = 0, CW_BAR = 4096;

constexpr int RING_OFF = 0, RING_BYTES = 131072;
constexpr int LDSCTL_OFF = RING_BYTES, MISC_OFF = LDSCTL_OFF + 320;
constexpr int EPI_OFF = RING_BYTES + 512;
constexpr int LDS_BYTES = 147456;

#define GAS __attribute__((address_space(1)))
#define LAS __attribute__((address_space(3)))
typedef unsigned short bf16;
typedef unsigned v4u __attribute__((ext_vector_type(4)));
typedef unsigned v2u __attribute__((ext_vector_type(2)));
typedef float f32x4 __attribute__((ext_vector_type(4)));
typedef float f32x2v __attribute__((ext_vector_type(2)));
#define LDS_WAIT() asm volatile("s_waitcnt lgkmcnt(0)" ::: "memory")
#define VM_WAIT() asm volatile("s_waitcnt vmcnt(0)" ::: "memory")
__device__ __forceinline__ unsigned f2bf(float f) { unsigned u = __builtin_bit_cast(unsigned, f); return (u + 0x7fffu + ((u >> 16) & 1u)) >> 16; }
__device__ __forceinline__ unsigned pk2(float lo, float hi) { return f2bf(lo) | (f2bf(hi) << 16); }
__device__ __forceinline__ float bflo(unsigned u) { return __builtin_bit_cast(float, u << 16); }
__device__ __forceinline__ float bfhi(unsigned u) { return __builtin_bit_cast(float, u & 0xffff0000u); }
#define XB_TMO      128
#define XB_XCNT(j)  (256  + 64 * (j))
#define XB_XSUB(j)  (1280 + 64 * (j))
#define XB_XGEN(j)  (2304 + 64 * (j))
#define XB_TOP      3328
#define XB_TOPGEN   3392
#define XCD_BAR_WORDS 3456
#define XB_SPIN_CAP (1u << 18)

__device__ __forceinline__ unsigned xb_ld(unsigned* p)              { return __hip_atomic_load(p, __ATOMIC_RELAXED, __HIP_MEMORY_SCOPE_AGENT); }
__device__ __forceinline__ unsigned xb_add(unsigned* p, unsigned v) { return __hip_atomic_fetch_add(p, v, __ATOMIC_RELAXED, __HIP_MEMORY_SCOPE_AGENT); }
__device__ __forceinline__ unsigned xb_xcc_id() { return (unsigned)__builtin_amdgcn_s_getreg((3 << 11) | 20) & 0xFu; }
#define XB_SPIN(cond, bar) do { unsigned _sp = 0; while (cond) { __builtin_amdgcn_s_sleep(1); \
    if ((++_sp & 255u) == 0u) { if (xb_ld(&(bar)[XB_TMO])) break; if (_sp > XB_SPIN_CAP) { atomicAdd(&(bar)[XB_TMO], 1u); break; } } } } while (0)

struct XcdBarrier {
    unsigned* bar; unsigned x;
    volatile LAS unsigned* st;
};

__device__ __forceinline__ XcdBarrier xcd_barrier_post(unsigned* bar, volatile LAS unsigned* st) {
    XcdBarrier b; b.bar = bar; b.x = xb_xcc_id(); b.st = st;
    if (threadIdx.x == 0) (void)xb_add(&bar[XB_XCNT(b.x)], 1u);
    return b;
}
__device__ __forceinline__ void xcd_barrier_complete(unsigned* bar, unsigned x, unsigned& nloc, unsigned& nx) {
    const unsigned G = gridDim.x * gridDim.y * gridDim.z;
    unsigned sum, cnt, mine, sp = 0u;
    for (;;) {
        sum = 0u; cnt = 0u; mine = 0u;
#pragma unroll
        for (unsigned j = 0; j < 16; ++j) { const unsigned c = xb_ld(&bar[XB_XCNT(j)]); sum += c; cnt += (c > 0u) ? 1u : 0u; mine = (j == x) ? c : mine; }
        if (sum == G) break;
        __builtin_amdgcn_s_sleep(1);
        if ((++sp & 255u) == 0u) { if (xb_ld(&bar[XB_TMO])) break; if (sp > XB_SPIN_CAP) { atomicAdd(&bar[XB_TMO], 1u); break; } }
    }
    nloc = mine > 0u ? mine : 1u; nx = cnt > 0u ? cnt : 1u;
}

__device__ __forceinline__ void xcd_barrier(const XcdBarrier& b, const bool is_t0  ) {
    asm volatile("s_waitcnt vmcnt(0)" ::: "memory");
    __syncthreads();
    if (is_t0) {
        unsigned* bar = b.bar;
        __builtin_amdgcn_s_waitcnt(0);
        unsigned nloc = b.st[0], nx = b.st[1];
        if (nloc == 0u) { xcd_barrier_complete(bar, b.x, nloc, nx); b.st[0] = nloc; b.st[1] = nx; }
        const unsigned old = xb_add(&bar[XB_XSUB(b.x)], 1u);
        const unsigned gen = old / nloc;
        if (old + 1u == (gen + 1u) * nloc) {
            __builtin_amdgcn_fence(__ATOMIC_RELEASE, "agent");
            asm volatile("s_waitcnt vmcnt(0)" ::: "memory");
            const unsigned og = xb_add(&bar[XB_TOP], 1u);
            const unsigned tg = og / nx;
            if (og + 1u == (tg + 1u) * nx) xb_add(&bar[XB_TOPGEN], 1u);
            else XB_SPIN(xb_ld(&bar[XB_TOPGEN]) == tg, bar);
            __builtin_amdgcn_fence(__ATOMIC_ACQUIRE, "agent");
            xb_add(&bar[XB_XGEN(b.x)], 1u);
            asm volatile("s_waitcnt vmcnt(0)" ::: "memory");
        } else {
            XB_SPIN(xb_ld(&bar[XB_XGEN(b.x)]) == gen, bar);
            __builtin_amdgcn_fence(__ATOMIC_ACQUIRE, "agent");
            asm volatile("s_waitcnt vmcnt(0)" ::: "memory");
        }
    }
    __syncthreads();
}
struct U2 { unsigned lo, up; };
__device__ __forceinline__ U2 swap_self(unsigned v) {
    unsigned w = v; asm volatile("" : "+v"(w));
    auto rr = __builtin_amdgcn_permlane32_swap(v, w, false, false); U2 r; r.lo = rr[0]; r.up = rr[1]; return r;
}
__device__ __forceinline__ float swap_add(float v) { const U2 r = swap_self(__builtin_bit_cast(unsigned, v)); return __builtin_bit_cast(float, r.lo) + __builtin_bit_cast(float, r.up); }
__device__ __forceinline__ float swap_max(float v) { const U2 r = swap_self(__builtin_bit_cast(unsigned, v)); return fmaxf(__builtin_bit_cast(float, r.lo), __builtin_bit_cast(float, r.up)); }
template <int O> __device__ __forceinline__ unsigned xor_u(unsigned v) {
    if constexpr (O == 1) return (unsigned)__builtin_amdgcn_update_dpp(0, (int)v, 0xB1, 0xF, 0xF, true);
    else if constexpr (O == 2) return (unsigned)__builtin_amdgcn_update_dpp(0, (int)v, 0x4E, 0xF, 0xF, true);
    else return (unsigned)__builtin_amdgcn_ds_swizzle((int)v, (O << 10) | 0x1F);
}
template <int O> __device__ __forceinline__ float xor_f(float v) { return __builtin_bit_cast(float, xor_u<O>(__builtin_bit_cast(unsigned, v))); }
__device__ __forceinline__ float half_sum32(float v) {
    v += xor_f<1>(v); v += xor_f<2>(v); v += xor_f<4>(v); v += xor_f<8>(v); v += xor_f<16>(v); return v;
}
__device__ __forceinline__ float wave_sum(float v) {
    return swap_add(half_sum32(v));
}
__device__ __forceinline__ float wave_max(float v) {
    v = fmaxf(v, xor_f<1>(v)); v = fmaxf(v, xor_f<2>(v)); v = fmaxf(v, xor_f<4>(v)); v = fmaxf(v, xor_f<8>(v)); v = fmaxf(v, xor_f<16>(v));
    return swap_max(v);
}
__device__ __forceinline__ int wave_sum_i(int v) {
    v += (int)xor_u<1>((unsigned)v); v += (int)xor_u<2>((unsigned)v); v += (int)xor_u<4>((unsigned)v); v += (int)xor_u<8>((unsigned)v); v += (int)xor_u<16>((unsigned)v);
    const U2 r = swap_self((unsigned)v); return (int)(r.lo + r.up);
}
__device__ __forceinline__ float dot4(f32x4 a, f32x4 b) { return (a.x * b.x + a.y * b.y) + (a.z * b.z + a.w * b.w); }

struct Ctx { int tid, lane, wave, G, vcu, gw, NGW; LAS unsigned char* lds; };
__device__ __forceinline__ Ctx fresh(const Ctx& X) {
    Ctx Y = X; int l; asm volatile("v_mbcnt_lo_u32_b32 %0, -1, 0\n\tv_mbcnt_hi_u32_b32 %0, -1, %0" : "=v"(l));
    asm volatile("" : "+s"(Y.wave), "+s"(Y.vcu), "+s"(Y.G));
    Y.lane = l; Y.tid = Y.wave * 64 + l; Y.gw = Y.vcu * NWAVES + Y.wave; Y.NGW = Y.G * NWAVES; return Y;
}

enum { TR_ID = 0, TR_GLU = 1, TR_QKV = 2, TR_DSA = 3 };
__device__ __forceinline__ int tr_src(int r, int mode, int Nsrc) {
    if (mode == TR_ID) return r < Nsrc ? r : -1;
    if (mode == TR_GLU) return ((r >> 7) & 1) * 2048 + (r >> 8) * 128 + (r & 127);
    const int q = r & 127, wc = q >> 5, n = (q >> 4) & 1, f4 = q & 15;
    if (r < 4096 && mode == TR_DSA) return (r & ~127) + 16 * wc + f4 + 64 * n;
    if (r < 6144) return (r & ~127) + 32 * wc + 2 * (f4 & 12) + 4 * n + (f4 & 3);
    if (mode == TR_QKV) return -1;
    if (r < 7168) return (r & ~127) + 64 * (wc >> 1) + 16 * (wc & 1) + f4 + 32 * n;
    if (r < 7168 + 128) { if (wc < 2) return 7168 + 16 * wc + f4 + 32 * n; if (wc == 2 && n == 0) return 7232 + f4; }
    return -1;
}
__device__ __forceinline__ void tr_item(const float* W, int K, int Nsrc, bf16* WT, int mode, int item, int nblk, int lane, LAS unsigned char* stg) {
    const int kb = item / nblk, nb = item - kb * nblk, k0 = 64 * kb, r0 = 128 * nb + 2 * lane, sc4 = tr_src(r0 & ~3, mode, Nsrc), sc = sc4 < 0 ? -1 : sc4 + (r0 & 3);
    f32x2v v[64];
    if (sc >= 0) { const float* src = W + (size_t)k0 * Nsrc + sc;
#pragma unroll
        for (int i = 0; i < 64; ++i) v[i] = *(const f32x2v*)(src + (size_t)i * Nsrc); }
    else {
#pragma unroll
        for (int i = 0; i < 64; ++i) v[i] = (f32x2v){0.f, 0.f}; }
#pragma unroll
    for (int j = 0; j < 2; ++j) {
#pragma unroll
        for (int q = 0; q < 8; ++q) { v4u o; o.x = pg8::cvt_pk_bf16(v[8 * q][j], v[8 * q + 1][j]); o.y = pg8::cvt_pk_bf16(v[8 * q + 2][j], v[8 * q + 3][j]); o.z = pg8::cvt_pk_bf16(v[8 * q + 4][j], v[8 * q + 5][j]); o.w = pg8::cvt_pk_bf16(v[8 * q + 6][j], v[8 * q + 7][j]);
            const int slot = ((((q ^ (lane & 7)) << 1) | j) ^ ((lane >> 3) & 1));
            *(LAS v4u*)(stg + lane * 256 + slot * 16) = o; } }
    LDS_WAIT();
    bf16* dst = WT + (size_t)(128 * nb + (lane >> 3)) * K + k0 + 8 * (lane & 7);
#pragma unroll
    for (int s2 = 0; s2 < 16; ++s2) { const int n = 8 * s2 + (lane >> 3), pp = n >> 1, q = lane & 7;
        const int slot = ((((q ^ (pp & 7)) << 1) | (n & 1)) ^ ((pp >> 3) & 1));
        const v4u o = *(LAS v4u*)(stg + pp * 256 + slot * 16);
        *(v4u*)(dst + (size_t)(8 * s2) * K) = o; }
    LDS_WAIT();
}
__device__ __forceinline__ void tr_matrix(const Ctx& X, const float* W, int K, int Nsrc, int Ndst, bf16* WT, int mode, int& rot, int gw, int ngw) {
    const int nblk = Ndst / 128, nitems = (K / 64) * nblk;
    int first = gw - rot; if (first < 0) first += ngw;
    for (int it = first; it < nitems; it += ngw) tr_item(W, K, Nsrc, WT, mode, it, nblk, X.lane, X.lds + RING_OFF + X.wave * 16384);
    rot = (rot + nitems) % ngw;
}
__device__ __forceinline__ void ph_rope_tables(const Ctx& X, const int* positions, float* CS, float* CS2) {
    for (int idx = X.gw * 64 + X.lane; idx < M * 96; idx += X.NGW * 64) {
        const int m = idx / 96, i = idx - m * 96; const float pos = (float)positions[m];
        if (i < 64) { const float a = pos * exp2f(-(float)i * (13.287712379549449f / 64.0f)); CS[(size_t)m * 128 + i] = cosf(a); CS[(size_t)m * 128 + 64 + i] = sinf(a); }
        else { const int i2 = i - 64; const float a = pos * exp2f(-(float)i2 * (13.287712379549449f / 32.0f)); CS2[(size_t)m * 64 + i2] = cosf(a); CS2[(size_t)m * 64 + 32 + i2] = sinf(a); }
    }
}
__device__ __forceinline__ void ph_mod(const Ctx& X, const float* cin, const float* ada_w, const float* ada_b, float* MOD) {
    LAS float* condl = (LAS float*)(X.lds + RING_OFF);
    LAS float* red = (LAS float*)(X.lds + RING_OFF + 32768);
    for (int i = X.tid; i < NB * D; i += 512) { const float c = cin[i]; condl[i] = c / (1.0f + __expf(-c)); }
    __syncthreads();
    for (int it = (int)((blockIdx.x + X.G - 64 % X.G) % X.G); it < NL * 48; it += X.G) {
        const int l = it / 48, n0 = (it % 48) * 256;
        const float* W = ada_w + (size_t)l * D * (6 * D) + n0 + 4 * X.lane;
        f32x4 a0 = {0.f, 0.f, 0.f, 0.f}, a1 = a0, a2 = a0, a3 = a0;
#pragma unroll 8
        for (int kk = 0; kk < 256; ++kk) { const int k = X.wave * 256 + kk; const f32x4 w = *(const f32x4*)(W + (size_t)k * (6 * D));
            a0 += condl[k] * w; a1 += condl[2048 + k] * w; a2 += condl[4096 + k] * w; a3 += condl[6144 + k] * w; }
        *(LAS f32x4*)(red + (X.wave * 4 + 0) * 256 + 4 * X.lane) = a0; *(LAS f32x4*)(red + (X.wave * 4 + 1) * 256 + 4 * X.lane) = a1;
        *(LAS f32x4*)(red + (X.wave * 4 + 2) * 256 + 4 * X.lane) = a2; *(LAS f32x4*)(red + (X.wave * 4 + 3) * 256 + 4 * X.lane) = a3;
        __syncthreads();
        for (int o = X.tid; o < 1024; o += 512) { const int b = o >> 8, c = o & 255; float s = 0.f;
#pragma unroll
            for (int w = 0; w < 8; ++w) s += red[(w * 4 + b) * 256 + c];
            MOD[(size_t)(l * NB + b) * (6 * D) + n0 + c] = s + ada_b[(size_t)l * (6 * D) + n0 + c]; }
        __syncthreads();
    }
}
__device__ __forceinline__ void ph_ln_mod(const Ctx& X, const float* x, const float* lng, const float* modl, int sh_off, int sc_off, bf16* H) {
    const int lane = X.lane;
    for (int b = 0; b < NB; ++b) {
        if (X.gw >= S) break;
        const float* mb = modl + (size_t)b * (6 * D);
        f32x4 ga[8], sh[8];
#pragma unroll
        for (int j = 0; j < 8; ++j) { const int col = 4 * lane + 256 * j; ga[j] = *(const f32x4*)(lng + col) * (1.0f + *(const f32x4*)(mb + sc_off + col)); sh[j] = *(const f32x4*)(mb + sh_off + col); }
        f32x4 vn[8];
        { const f32x4* xr = (const f32x4*)(x + ((size_t)b * S + X.gw) * D) + lane;
#pragma unroll
          for (int j = 0; j < 8; ++j) vn[j] = xr[64 * j]; }
        for (int t = X.gw; t < S; t += X.NGW) {
            f32x4 v[8];
#pragma unroll
            for (int j = 0; j < 8; ++j) v[j] = vn[j];
            if (t + X.NGW < S) { const f32x4* xr = (const f32x4*)(x + ((size_t)b * S + t + X.NGW) * D) + lane;
#pragma unroll
                for (int j = 0; j < 8; ++j) vn[j] = xr[64 * j]; }
            float ss = 0.f;
#pragma unroll
            for (int j = 0; j < 8; ++j) ss += dot4(v[j], v[j]);
            ss = wave_sum(ss);
            const float r = 1.0f / sqrtf(ss * (1.0f / D) + EPS);
            bf16* hrow = H + ((size_t)b * S + t) * D + 4 * lane;
#pragma unroll
            for (int j = 0; j < 8; ++j) { const f32x4 y = v[j] * r * ga[j] + sh[j];
                v2u o; o.x = pk2(y.x, y.y); o.y = pk2(y.z, y.w);
                *(v2u*)(hrow + 256 * j) = o; }
        }
    }
}
typedef _Float16 h16x8 __attribute__((ext_vector_type(8)));
__device__ __forceinline__ void ph_ln_mod_h(const Ctx& X, const _Float16* x, const float* lng, const float* modl, int sh_off, int sc_off, bf16* H) {
    const int lane = X.lane;
    for (int b = 0; b < NB; ++b) {
        if (X.gw >= S) break;
        const float* mb = modl + (size_t)b * (6 * D);
        f32x4 ga[8], sh[8];
#pragma unroll
        for (int j = 0; j < 8; ++j) { const int col = 8 * lane + 512 * (j >> 1) + 4 * (j & 1); ga[j] = *(const f32x4*)(lng + col) * (1.0f + *(const f32x4*)(mb + sc_off + col)); sh[j] = *(const f32x4*)(mb + sh_off + col); }
        h16x8 vn[4];
        { const h16x8* xr = (const h16x8*)(x + ((size_t)b * S + X.gw) * D) + lane;
#pragma unroll
          for (int j = 0; j < 4; ++j) vn[j] = xr[64 * j]; }
        for (int t = X.gw; t < S; t += X.NGW) {
            f32x4 v[8];
#pragma unroll
            for (int j = 0; j < 4; ++j) { v[2 * j] = (f32x4){(float)vn[j][0], (float)vn[j][1], (float)vn[j][2], (float)vn[j][3]}; v[2 * j + 1] = (f32x4){(float)vn[j][4], (float)vn[j][5], (float)vn[j][6], (float)vn[j][7]}; }
            if (t + X.NGW < S) { const h16x8* xr = (const h16x8*)(x + ((size_t)b * S + t + X.NGW) * D) + lane;
#pragma unroll
                for (int j = 0; j < 4; ++j) vn[j] = xr[64 * j]; }
            float ss = 0.f;
#pragma unroll
            for (int j = 0; j < 8; ++j) ss += dot4(v[j], v[j]);
            ss = wave_sum(ss);
            const float r = 1.0f / sqrtf(ss * (1.0f / D) + EPS);
            bf16* hrow = H + ((size_t)b * S + t) * D + 8 * lane;
#pragma unroll
            for (int j = 0; j < 4; ++j) { const f32x4 y0 = v[2 * j] * r * ga[2 * j] + sh[2 * j], y1 = v[2 * j + 1] * r * ga[2 * j + 1] + sh[2 * j + 1];
                v4u o; o.x = pk2(y0.x, y0.y); o.y = pk2(y0.z, y0.w); o.z = pk2(y1.x, y1.y); o.w = pk2(y1.z, y1.w);
                *(v4u*)(hrow + 512 * j) = o; }
        }
    }
}
__device__ __forceinline__ void ph_idx_scores(const Ctx& X, const bf16* QI, const bf16* KI, const float* WI, float* SC) {
    typedef short bf16x8 __attribute__((ext_vector_type(8)));
    typedef float f32x16 __attribute__((ext_vector_type(16)));
    const int tid = X.tid, lane = X.lane, wid = X.wave, r32 = lane & 31, hi = lane >> 5;
    LAS char* lds = (LAS char*)(X.lds + RING_OFF);
    const __amdgpu_buffer_rsrc_t rK = __builtin_amdgcn_make_buffer_rsrc((void*)KI, (short)0, M * 64 * 2, 0x00020000);
    const __amdgpu_buffer_rsrc_t rQ = __builtin_amdgcn_make_buffer_rsrc((void*)QI, (short)0, M * 1024 * 2, 0x00020000);
    const __amdgpu_buffer_rsrc_t rS = __builtin_amdgcn_make_buffer_rsrc((void*)SC, (short)0, 0x40000000, 0x00020000);
    unsigned st_g[4], st_l[4];
#pragma unroll
    for (int j = 0; j < 4; ++j) { const int p = tid + 512 * j, key = p >> 3, pc = p & 7; st_g[j] = (unsigned)p * 16u; st_l[j] = (unsigned)(key * 128 + ((pc ^ ((key >> 1) & 7)) << 4)); }
    unsigned rd[4];
#pragma unroll
    for (int d0 = 0; d0 < 4; ++d0) rd[d0] = (unsigned)(r32 * 128 + (((2 * d0 + hi) ^ ((r32 >> 1) & 7)) << 4));
    const int qsel = (r32 >> 2) & 1, hsel = (r32 & 3) + 4 * (r32 >> 3);
    for (int slot = X.vcu; slot < 256; slot += X.G) {
        for (int b = 0; b < NB; ++b) {
            const int blk = (b & 1) ? 255 - slot : slot;
            const int t0 = blk * 16, m0 = b * S + t0, tq = t0 + 2 * wid;
            const int nch = (t0 + 15) / 256 + 1;
            bf16x8 afr[4];
#pragma unroll
            for (int d0 = 0; d0 < 4; ++d0) afr[d0] = __builtin_bit_cast(bf16x8, __builtin_amdgcn_raw_buffer_load_b128(rQ, (unsigned)((2 * wid + qsel) * 1024 + hsel * 64 + d0 * 16 + hi * 8) * 2u, (unsigned)m0 * 2048u, 0));
            float wv[16];
#pragma unroll
            for (int q = 0; q < 4; ++q) { const f32x4 w4 = *(const f32x4*)(WI + (size_t)(m0 + 2 * wid + hi) * 16 + 4 * q);
                wv[4 * q] = w4.x; wv[4 * q + 1] = w4.y; wv[4 * q + 2] = w4.z; wv[4 * q + 3] = w4.w; }
            v4u st[4];
            __syncthreads();
#pragma unroll
            for (int j = 0; j < 4; ++j) st[j] = __builtin_amdgcn_raw_buffer_load_b128(rK, st_g[j], (unsigned)(b * S) * 128u, 0);
#pragma unroll
            for (int j = 0; j < 4; ++j) *(LAS v4u*)(lds + st_l[j]) = st[j];
            __syncthreads();
            for (int c = 0; c < nch; ++c) {
                const int kb = c * 256, buf = c & 1; const bool more = c + 1 < nch;
                if (more) {
#pragma unroll
                    for (int j = 0; j < 4; ++j) st[j] = __builtin_amdgcn_raw_buffer_load_b128(rK, st_g[j], (unsigned)(b * S + kb + 256) * 128u, 0); }
                const LAS char* cb = lds + buf * 32768;
                const unsigned srow = (unsigned)(m0 + 2 * wid) * (unsigned)(S * 4) + (unsigned)kb * 4u;
                const int ngrp = ((tq + 1 - kb) >> 5) + 1;
#define IDX_LOADB(GP, B0, B1) _Pragma("unroll") for (int d0 = 0; d0 < 4; ++d0) { B0[d0] = *(const LAS bf16x8*)(cb + (2 * (GP)) * 4096 + rd[d0]); B1[d0] = *(const LAS bf16x8*)(cb + (2 * (GP) + 1) * 4096 + rd[d0]); }
#define IDX_MMA(B0, B1, A0, A1) _Pragma("unroll") for (int d0 = 0; d0 < 4; ++d0) { A0 = __builtin_amdgcn_mfma_f32_32x32x16_bf16(afr[d0], B0[d0], A0, 0, 0, 0); A1 = __builtin_amdgcn_mfma_f32_32x32x16_bf16(afr[d0], B1[d0], A1, 0, 0, 0); }
#define IDX_FIN(ACC, GRP) do { typedef int i32x16 __attribute__((ext_vector_type(16))); \
                    const f32x16 rl_ = __builtin_bit_cast(f32x16, __builtin_elementwise_max(__builtin_bit_cast(i32x16, ACC), (i32x16)(0)));     \
                    float s0_ = 0.f, s1_ = 0.f; _Pragma("unroll") for (int r = 0; r < 16; r += 2) { s0_ = __builtin_fmaf(wv[r], rl_[r], s0_); s1_ = __builtin_fmaf(wv[r + 1], rl_[r + 1], s1_); } \
                    __builtin_amdgcn_raw_buffer_store_b32(__builtin_bit_cast(unsigned, s0_ + s1_), rS, (unsigned)(hi * (S * 4) + ((GRP) * 32 + r32) * 4), srow, 0); } while (0)
                if (ngrp >= 8) {
                    bf16x8 bA[4], bB[4]; f32x16 pa0 = {}, pa1 = {};
                    IDX_LOADB(0, bA, bB); IDX_MMA(bA, bB, pa0, pa1);
#pragma unroll
                    for (int gp = 0; gp < 4; ++gp) {
                        f32x16 na0 = {}, na1 = {};
                        if (gp < 3) { IDX_LOADB(gp + 1, bA, bB); IDX_MMA(bA, bB, na0, na1); }
                        IDX_FIN(pa0, 2 * gp); IDX_FIN(pa1, 2 * gp + 1);
                        pa0 = na0; pa1 = na1;
                    }
                } else {
#pragma unroll
                    for (int gp = 0; gp < 4; ++gp) {
                        if (2 * gp < ngrp) {
                            bf16x8 bA[4], bB[4]; f32x16 pa0 = {}, pa1 = {};
                            IDX_LOADB(gp, bA, bB); IDX_MMA(bA, bB, pa0, pa1);
                            IDX_FIN(pa0, 2 * gp); IDX_FIN(pa1, 2 * gp + 1);
                        }
                    }
                }
#undef IDX_LOADB
#undef IDX_MMA
#undef IDX_FIN
                if (more) {
#pragma unroll
                    for (int j = 0; j < 4; ++j) *(LAS v4u*)(lds + (buf ^ 1) * 32768 + st_l[j]) = st[j]; }
                __syncthreads();
            }
        }
    }
}
#define SEL_WRLANE(w, v, LN) asm("s_nop 1\n\tv_writelane_b32 %0, %1, %2" : "+v"(w) : "s"(v), "i"(LN))
template <int NG8>
__device__ __forceinline__ void sel_row(int lane, int t, __amdgpu_buffer_rsrc_t rS, unsigned row_off, unsigned* bw) {
    constexpr int NR = 8 * NG8, J0 = NR - 8;
    unsigned key[NR];
    const unsigned lane4 = (unsigned)lane * 4u;
#pragma unroll
    for (int j = 0; j < J0; ++j) key[j] = __builtin_amdgcn_raw_buffer_load_b32(rS, lane4, row_off + 256u * j, 0);
#pragma unroll
    for (int j = J0; j < NR; ++j) { const int d4 = 4 * (t - 64 * j); int v4 = (int)lane4 < d4 ? (int)lane4 : d4; v4 = v4 > 0 ? v4 : 0;
        key[j] = __builtin_amdgcn_raw_buffer_load_b32(rS, (unsigned)v4, row_off + 256u * j, 0); }
    asm volatile("" ::: "memory");
#pragma unroll
    for (int j = 0; j < NR; ++j) { const unsigned u = key[j]; const unsigned img = u ^ ((unsigned)((int)u >> 31) | 0x80000000u);
        key[j] = (j < J0 || lane <= t - 64 * j) ? img : 0u; }
    unsigned T = 0u; bool exact = false;
#pragma unroll 1
    for (int bit = 31; bit >= 0; --bit) { const unsigned cand = T | (1u << bit); int cnt = 0;
#pragma unroll
        for (int g8 = 0; g8 < NG8; ++g8) { unsigned long long m0, m1, m2, m3, m4, m5, m6, m7;
            asm volatile("v_cmp_ge_u32_e64 %0, %8, %16\n\tv_cmp_ge_u32_e64 %1, %9, %16\n\tv_cmp_ge_u32_e64 %2, %10, %16\n\tv_cmp_ge_u32_e64 %3, %11, %16\n\t"
                         "v_cmp_ge_u32_e64 %4, %12, %16\n\tv_cmp_ge_u32_e64 %5, %13, %16\n\tv_cmp_ge_u32_e64 %6, %14, %16\n\tv_cmp_ge_u32_e64 %7, %15, %16"
                         : "=s"(m0), "=s"(m1), "=s"(m2), "=s"(m3), "=s"(m4), "=s"(m5), "=s"(m6), "=s"(m7)
                         : "v"(key[g8 * 8]), "v"(key[g8 * 8 + 1]), "v"(key[g8 * 8 + 2]), "v"(key[g8 * 8 + 3]), "v"(key[g8 * 8 + 4]), "v"(key[g8 * 8 + 5]), "v"(key[g8 * 8 + 6]), "v"(key[g8 * 8 + 7]), "v"(cand));
            cnt += (__popcll(m0) + __popcll(m1)) + (__popcll(m2) + __popcll(m3)) + (__popcll(m4) + __popcll(m5)) + (__popcll(m6) + __popcll(m7)); }
        if (cnt >= TOPK) T = cand;
        if (cnt == TOPK) { exact = true; break; } }
    unsigned w0 = 0u, w1 = 0u;
    if (exact) {
#pragma unroll
        for (int j = 0; j < NR; ++j) { const unsigned long long ms = __ballot(key[j] >= T);
            { const unsigned mlo = (unsigned)ms, mhi = (unsigned)(ms >> 32);
            if (j < 32) { SEL_WRLANE(w0, mlo, (2 * j) & 63); SEL_WRLANE(w0, mhi, (2 * j + 1) & 63); }
            else { SEL_WRLANE(w1, mlo, (2 * j) & 63); SEL_WRLANE(w1, mhi, (2 * j + 1) & 63); } } }
    } else {
        int cgt = 0;
#pragma unroll
        for (int j = 0; j < NR; ++j) cgt += __popcll(__ballot(key[j] > T));
        const int need = TOPK - cgt; int run = 0;
#pragma unroll
        for (int j = 0; j < NR; ++j) { const bool gt = key[j] > T, eq = key[j] == T;
            const unsigned long long meq = __ballot(eq);
            const int rank = run + (int)__builtin_amdgcn_mbcnt_hi((unsigned)(meq >> 32), __builtin_amdgcn_mbcnt_lo((unsigned)meq, 0u));
            const bool sel = gt || (eq && rank < need); run += __popcll(meq);
            const unsigned long long ms = __ballot(sel);
            { const unsigned mlo = (unsigned)ms, mhi = (unsigned)(ms >> 32);
            if (j < 32) { SEL_WRLANE(w0, mlo, (2 * j) & 63); SEL_WRLANE(w0, mhi, (2 * j + 1) & 63); }
            else { SEL_WRLANE(w1, mlo, (2 * j) & 63); SEL_WRLANE(w1, mhi, (2 * j + 1) & 63); } } }
    }
    bw[lane] = w0; bw[64 + lane] = w1;
}
__device__ __forceinline__ void ph_topk_select(const Ctx& X, const float* SC, unsigned* BITS) {
    const int lane = X.lane;
    const __amdgpu_buffer_rsrc_t rS = __builtin_amdgcn_make_buffer_rsrc((void*)SC, (short)0, 0x10000000, 0x00020000);
    for (int i = X.gw; i < M; i += X.NGW) {
        const int k = i / 2048, p = i % 2048, bb = k >> 1, t = (k & 1) ? (S - 1 - p) : p, m = bb * S + t;
        unsigned* bw = BITS + (size_t)m * 128;
        if (t < TOPK) {
#pragma unroll
            for (int q = 0; q < 2; ++q) { const int w = lane + 64 * q, lo = 32 * w; bw[w] = (t >= lo + 31) ? 0xffffffffu : (t < lo ? 0u : ((2u << (t - lo)) - 1u)); }
            continue;
        }
        const unsigned row_off = (unsigned)m * (unsigned)(S * 4);
        switch (t >> 9) {
            case 0: sel_row<1>(lane, t, rS, row_off, bw); break;
            case 1: sel_row<2>(lane, t, rS, row_off, bw); break;
            case 2: sel_row<3>(lane, t, rS, row_off, bw); break;
            case 3: sel_row<4>(lane, t, rS, row_off, bw); break;
            case 4: sel_row<5>(lane, t, rS, row_off, bw); break;
            case 5: sel_row<6>(lane, t, rS, row_off, bw); break;
            case 6: sel_row<7>(lane, t, rS, row_off, bw); break;
            default: sel_row<8>(lane, t, rS, row_off, bw); break;
        }
    }
}
__device__ __forceinline__ void ph_s5_pre(const Ctx& X, const float* lre, const float* lim, const float* logdt, const float* bre, const float* bim, const float* cre, const float* cim,
                                          float* S5C, bf16* B1, bf16* B3) {
    LAS float* APr = (LAS float*)(X.lds + RING_OFF);
    LAS float* APi = APr + 17 * 64;
    LAS float* BBr = APi + 17 * 64;
    LAS float* BBi = BBr + 1024;
    LAS float* CR = BBi + 1024;
    LAS float* CI = CR + 1024;
    LAS float* KT = CI + 1024;
    float* AT16R = S5C; float* AT16I = S5C + G5 * P5;
    for (int w2 = blockIdx.x; 2 * w2 < G5; w2 += X.G) for (int e2 = 0; e2 < 2; ++e2) {
        const int g = 2 * w2 + e2;
        __syncthreads();
        if (X.tid < 64) { const int p = X.tid, gp = g * 64 + p;
            const float dt = expf(logdt[g]), lr = lre[gp], li = lim[gp];
            const float mag = expf(lr * dt), ang = li * dt, ar = mag * cosf(ang), ai = mag * sinf(ang);
            const float den = lr * lr + li * li;
            const float fr = ((ar - 1.0f) * lr + ai * li) / den, fi = (ai * lr - (ar - 1.0f) * li) / den;
            float pr = 1.0f, pi = 0.0f;
            for (int tau = 0; tau <= 16; ++tau) { APr[tau * 64 + p] = pr; APi[tau * 64 + p] = pi; const float nr = pr * ar - pi * ai, ni = pr * ai + pi * ar; pr = nr; pi = ni; }
            AT16R[gp] = APr[16 * 64 + p]; AT16I[gp] = APi[16 * 64 + p];
            for (int c = 0; c < C5; ++c) { const float br = bre[(size_t)gp * C5 + c], bi = bim[(size_t)gp * C5 + c]; BBr[p * 16 + c] = fr * br - fi * bi; BBi[p * 16 + c] = fr * bi + fi * br; } }
        for (int i = X.tid; i < 1024; i += 512) { CR[i] = cre[(size_t)g * 1024 + i]; CI[i] = cim[(size_t)g * 1024 + i]; }
        __syncthreads();
        for (int o = X.tid; o < 4096; o += 512) { const int tau = o >> 8, c = (o >> 4) & 15, cp = o & 15; float sacc = 0.f;
            for (int p = 0; p < 64; ++p) { const float ar_ = APr[tau * 64 + p], ai_ = APi[tau * 64 + p], br_ = BBr[p * 16 + cp], bi_ = BBi[p * 16 + cp];
                sacc += CR[c * 64 + p] * (ar_ * br_ - ai_ * bi_) - CI[c * 64 + p] * (ar_ * bi_ + ai_ * br_); }
            KT[o] = sacc; }
        __syncthreads();
        bf16* b3 = B3 + (size_t)g * 256 * 384;
        for (int idx = X.tid; idx < 256 * 192; idx += 512) { const int n = idx / 192, kp = idx - n * 192, t = n >> 4, c = n & 15; float v[2];
#pragma unroll
            for (int e = 0; e < 2; ++e) { const int k = 2 * kp + e;
                if (k < 256) { const int sx = k >> 4, cp = k & 15; v[e] = (sx <= t) ? KT[((t - sx) << 8) + (c << 4) + cp] : 0.f; }
                else if (k < 320) { const int p = k - 256; v[e] = CR[c * 64 + p] * APr[(t + 1) * 64 + p] - CI[c * 64 + p] * APi[(t + 1) * 64 + p]; }
                else { const int p = k - 320; v[e] = -(CR[c * 64 + p] * APi[(t + 1) * 64 + p] + CI[c * 64 + p] * APr[(t + 1) * 64 + p]); } }
            *(unsigned*)(b3 + (size_t)n * 384 + 2 * kp) = pk2(v[0], v[1]); }
        bf16* b1 = B1 + (size_t)g * 256 * 256;
        for (int idx = X.tid; idx < 256 * 128; idx += 512) { const int n = idx >> 7, kp = idx & 127; float v[2] = {0.f, 0.f};
            if (n < 128) { const int ri = n >> 6, p = n & 63;
#pragma unroll
                for (int e = 0; e < 2; ++e) { const int k = 2 * kp + e, sx = k >> 4, cp = k & 15; const float ar_ = APr[(15 - sx) * 64 + p], ai_ = APi[(15 - sx) * 64 + p], br_ = BBr[p * 16 + cp], bi_ = BBi[p * 16 + cp];
                    v[e] = ri ? (ar_ * bi_ + ai_ * br_) : (ar_ * br_ - ai_ * bi_); } }
            *(unsigned*)(b1 + (size_t)n * 256 + 2 * kp) = pk2(v[0], v[1]); }
    }
    __syncthreads();
}
__device__ __forceinline__ void ph_s5_carry(const Ctx& X, const float* S5C, const float* E, bf16* AG) {
    const float* AT16R = S5C; const float* AT16I = S5C + G5 * P5;
    const int lane = X.lane;
    for (int it = X.gw; it < G5 * NB; it += X.NGW) {
        const int g = it >> 2, b = it & 3; const float ar = AT16R[g * 64 + lane], ai = AT16I[g * 64 + lane];
        const float* er = E + (size_t)(g * 1024 + b * 256) * 128 + lane; bf16* hrow = AG + (size_t)(g * 1024 + b * 256) * 384 + 256 + lane;
        float hr = 0.f, hi = 0.f;
        for (int k0 = 0; k0 < 256; k0 += 16) { float e0[16], e1[16];
#pragma unroll
            for (int q = 0; q < 16; ++q) { e0[q] = er[(size_t)(k0 + q) * 128]; e1[q] = er[(size_t)(k0 + q) * 128 + 64]; }
#pragma unroll
            for (int q = 0; q < 16; ++q) { hrow[(size_t)(k0 + q) * 384] = (bf16)f2bf(hr); hrow[(size_t)(k0 + q) * 384 + 64] = (bf16)f2bf(hi);
                const float nr = ar * hr - ai * hi + e0[q], ni = ar * hi + ai * hr + e1[q]; hr = nr; hi = ni; } }
    }
}
namespace att {
typedef short bf16x8 __attribute__((ext_vector_type(8)));
typedef short s16x4 __attribute__((ext_vector_type(4)));
typedef float f32x16 __attribute__((ext_vector_type(16)));
constexpr int KVBLK = 64, SHM_K = KVBLK * HD * 2, SHM_V = SHM_K;
constexpr int OFF_V = 0, OFF_K = 2 * SHM_V, OFF_WS = 2 * SHM_V + 2 * SHM_K, OFF_FLAG = OFF_WS + NWAVES * 256;
#define KSWZ(row, colB) ((row) * 256 + ((colB) ^ (((row) & 7) << 4)))
__device__ __forceinline__ int v_st(int k, int c) { const int kk = (k & ~0xC) | ((k & 4) << 1) | ((k & 8) >> 1); return ((kk >> 3) * 4 + (c >> 5)) * 512 + ((kk & 7) * 32 + (c & 31)) * 2; }
__device__ __forceinline__ int v_rd_base(int lane) { return ((lane & 3) << 3) | (((lane >> 2) & 3) << 6) | (((lane >> 4) & 1) << 5) | (((lane >> 5) & 1) << 8); }
constexpr int v_rd_off(int d0, int ks, int half) { return d0 * 512 + ks * 4096 + half * 2048; }
__device__ __forceinline__ int crow(int r, int hi) { return (r & 3) + 8 * (r >> 2) + 4 * hi; }
__device__ __forceinline__ unsigned cvtpk(float lo, float hi) { unsigned r; asm volatile("v_cvt_pk_bf16_f32 %0, %1, %2" : "=v"(r) : "v"(lo), "v"(hi)); return r; }
#define ATT_PK4(P, B_, OUT) do { unsigned a0 = cvtpk(P[B_+0], P[B_+1]), a1 = cvtpk(P[B_+2], P[B_+3]);                          \
        unsigned b0 = cvtpk(P[B_+4], P[B_+5]), b1 = cvtpk(P[B_+6], P[B_+7]);                                             \
        auto r0 = __builtin_amdgcn_permlane32_swap(a0, b0, false, false); auto r1 = __builtin_amdgcn_permlane32_swap(a1, b1, false, false); \
        v4u w = {r0[0], r1[0], r0[1], r1[1]}; OUT = *reinterpret_cast<bf16x8*>(&w); } while (0)

__device__ __forceinline__ void qkt(f32x16& p0, f32x16& p1, const LAS char* Kt, int r32, int hi, const bf16x8* qr) {
    p0 = f32x16{}; p1 = f32x16{};
    const LAS char* kb[4];
#pragma unroll
    for (int dd = 0; dd < 4; ++dd) kb[dd] = Kt + KSWZ(r32, (dd * 16 + hi * 8) * 2);
#pragma unroll
    for (int d0 = 0; d0 < 8; ++d0) { const LAS char* a = kb[d0 & 3] + (d0 >> 2) * 128;
        const bf16x8 b0 = *reinterpret_cast<const LAS bf16x8*>(a);
        const bf16x8 b1 = *reinterpret_cast<const LAS bf16x8*>(a + 32 * 256);
        p0 = __builtin_amdgcn_mfma_f32_32x32x16_bf16(b0, qr[d0], p0, 0, 0, 0);
        p1 = __builtin_amdgcn_mfma_f32_32x32x16_bf16(b1, qr[d0], p1, 0, 0, 0); }
}
__device__ __forceinline__ void pv_tile(f32x16* o, int vb0, bf16x8 pa0, bf16x8 pa1, bf16x8 pa2, bf16x8 pa3) {
#define ATT_TRRD(dst, off) asm volatile("ds_read_b64_tr_b16 %0, %1 offset:%2" : "=&v"(dst) : "v"(vb0), "i"(off) : "memory")
#define ATT_PV_D0(d0) do { s16x4 l0, l1, l2, l3, h0, h1, h2, h3; constexpr int b_ = v_rd_off(d0, 0, 0); \
        ATT_TRRD(l0, b_); ATT_TRRD(h0, b_ + 2048); ATT_TRRD(l1, b_ + 4096); ATT_TRRD(h1, b_ + 6144); ATT_TRRD(l2, b_ + 8192); ATT_TRRD(h2, b_ + 10240); ATT_TRRD(l3, b_ + 12288); ATT_TRRD(h3, b_ + 14336); \
        asm volatile("s_waitcnt lgkmcnt(0)" ::: "memory"); __builtin_amdgcn_sched_barrier(0);   \
        o[d0] = __builtin_amdgcn_mfma_f32_32x32x16_bf16((bf16x8){l0[0], l0[1], l0[2], l0[3], h0[0], h0[1], h0[2], h0[3]}, pa0, o[d0], 0, 0, 0);   \
        o[d0] = __builtin_amdgcn_mfma_f32_32x32x16_bf16((bf16x8){l1[0], l1[1], l1[2], l1[3], h1[0], h1[1], h1[2], h1[3]}, pa1, o[d0], 0, 0, 0);   \
        o[d0] = __builtin_amdgcn_mfma_f32_32x32x16_bf16((bf16x8){l2[0], l2[1], l2[2], l2[3], h2[0], h2[1], h2[2], h2[3]}, pa2, o[d0], 0, 0, 0);   \
        o[d0] = __builtin_amdgcn_mfma_f32_32x32x16_bf16((bf16x8){l3[0], l3[1], l3[2], l3[3], h3[0], h3[1], h3[2], h3[3]}, pa3, o[d0], 0, 0, 0); } while (0)
    ATT_PV_D0(0); ATT_PV_D0(1); ATT_PV_D0(2); ATT_PV_D0(3);
#undef ATT_PV_D0
#undef ATT_TRRD
}
__device__ __forceinline__ void store_o_rows(const f32x16* o, float scale, __amdgpu_buffer_rsrc_t rO, unsigned rowoff, unsigned soff) {
#pragma unroll
    for (int d0 = 0; d0 < 4; ++d0) {
        unsigned gx[4], gy[4];
#pragma unroll
        for (int g = 0; g < 4; ++g) { gx[g] = cvtpk(o[d0][4 * g] * scale, o[d0][4 * g + 1] * scale); gy[g] = cvtpk(o[d0][4 * g + 2] * scale, o[d0][4 * g + 3] * scale); }
#pragma unroll
        for (int k = 0; k < 4; k += 2) {
            auto rx = __builtin_amdgcn_permlane32_swap(gx[k], gx[k + 1], false, false); auto ry = __builtin_amdgcn_permlane32_swap(gy[k], gy[k + 1], false, false);
            const v4u w = {rx[0], ry[0], rx[1], ry[1]};
            __builtin_amdgcn_raw_buffer_store_b128(w, rO, rowoff + (unsigned)(d0 * 64 + k * 16), soff, 0); }
    }
}
template <bool NEEDMASK>
__device__ __forceinline__ void sb_tile(f32x16& p0, f32x16& p1, float& R, int dq, int hi) {
    float G[8];
#pragma unroll
    for (int half = 0; half < 2; ++half) {
        f32x16& p = half ? p1 : p0;
#pragma unroll
        for (int i = 0; i < 4; ++i) {
            float be[4], rc[4];
#pragma unroll
            for (int j = 0; j < 4; ++j) { const int c = j + 8 * i + 32 * half;
                const float e = __builtin_amdgcn_exp2f(p[4 * i + j]); rc[j] = __builtin_amdgcn_rcpf(1.0f + e); be[j] = 1.0f - rc[j];
                if (NEEDMASK) { const bool ok = c < dq; rc[j] = ok ? rc[j] : 1.0f; be[j] = ok ? be[j] : 0.0f; } }
            const float s2 = rc[3], s1 = s2 * rc[2], s0 = s1 * rc[1];
            G[4 * half + i] = s0 * rc[0];
            p[4 * i + 3] = be[3]; p[4 * i + 2] = be[2] * s2; p[4 * i + 1] = be[1] * s1; p[4 * i + 0] = be[0] * s0;
        }
    }
    float T[8], Pn[8];
#pragma unroll
    for (int g = 0; g < 8; ++g) { const U2 rr = swap_self(__builtin_bit_cast(unsigned, G[g]));
        const float lo = __builtin_bit_cast(float, rr.lo), up = __builtin_bit_cast(float, rr.up);
        T[g] = lo * up; Pn[g] = hi ? 1.0f : up; }
    float ST = 1.0f;
#pragma unroll
    for (int g = 7; g >= 0; --g) { const float A = R * ST * Pn[g]; f32x16& p = (g >> 2) ? p1 : p0; const int i = g & 3;
        p[4 * i + 0] *= A; p[4 * i + 1] *= A; p[4 * i + 2] *= A; p[4 * i + 3] *= A;
        ST *= T[g]; }
    R *= ST;
}

__device__ __forceinline__ bool R_any_alive(float R) { return __any(R != 0.0f) != 0; }
template <int MODE, bool STAGGER>
__device__ __forceinline__ void attn_phase(const Ctx& X, const bf16* QN, const bf16* KN, const bf16* VN, const unsigned* BITS, bf16* O) {
    const int tid = X.tid, wid = X.wave, lane = X.lane, r32 = lane & 31, hi = lane >> 5;
    LAS char* lds = (LAS char*)(X.lds + RING_OFF);
    const bool late = STAGGER && wid >= 4;
    LAS char* V_lds = lds; LAS char* K_lds = lds + 3 * SHM_V;
    volatile LAS unsigned* flags = (volatile LAS unsigned*)(lds + 3 * SHM_V + 2 * SHM_K);
    const int sr = tid >> 4, sc = (tid & 15) * 8, vst0 = v_st(sr, sc), vst1 = v_st(32 + sr, sc), kws = KSWZ(sr, sc * 2);
    const int vbase = (int)(uintptr_t)V_lds + v_rd_base(lane);
    const unsigned voff0 = (unsigned)(sr * D + sc) * 2u, voff1 = voff0 + 32u * D * 2u;
    const unsigned qoff = (unsigned)((wid * 32 + r32) * D + hi * 8) * 2u;
    const unsigned boff = (unsigned)(wid * 32 + r32) * 512u;
    const __amdgpu_buffer_rsrc_t rK = __builtin_amdgcn_make_buffer_rsrc((void*)KN, (short)0, M * D * 2, 0x00020000);
    const __amdgpu_buffer_rsrc_t rV = __builtin_amdgcn_make_buffer_rsrc((void*)VN, (short)0, M * D * 2, 0x00020000);
    const __amdgpu_buffer_rsrc_t rQ = __builtin_amdgcn_make_buffer_rsrc((void*)QN, (short)0, M * D * 2, 0x00020000);
    const __amdgpu_buffer_rsrc_t rO = __builtin_amdgcn_make_buffer_rsrc((void*)O, (short)0, M * D * 2, 0x00020000);
    const __amdgpu_buffer_rsrc_t rB = __builtin_amdgcn_make_buffer_rsrc((void*)(MODE == 1 ? (const void*)BITS : (const void*)QN), (short)0, M * 128 * 4, 0x00020000);
    for (int slot = X.vcu; slot < 256; slot += X.G) {
        const int bh = slot >> 2, sub = slot & 3, b = bh >> 4, h = bh & 15;
        const unsigned kvso = (unsigned)((b * S) * D + h * HD) * 2u;
        for (int qi = 0; qi < 4; ++qi) {
            const int qb = (qi == 0) ? sub : (qi == 1) ? 7 - sub : (qi == 2) ? 8 + sub : 15 - sub;
            const int P0 = qb * 256, NT = P0 / KVBLK + 4;
            const int qlo = P0 + wid * 32, qpos = qlo + r32;
            const unsigned qso = (unsigned)((b * S + P0) * D + h * HD) * 2u, bso = (unsigned)(b * S + P0) * 512u;
            bf16x8 qr[8];
#pragma unroll
            for (int d0 = 0; d0 < 8; ++d0) { const v4u q4 = __builtin_amdgcn_raw_buffer_load_b128(rQ, qoff + d0 * 32u, qso, 0); qr[d0] = __builtin_bit_cast(bf16x8, q4); }
            f32x16 o[4] = {};
            float R = 1.0f, m_reg = -1e30f, l_reg = 0.f;
            bf16x8 st_k0, st_k1, st_v0, st_v1;
#define ATT_KB(t) ((MODE == 0) ? (NT - 1 - (t)) * KVBLK : (t) * KVBLK)
#define ATT_LOAD(kb_) do { const unsigned so_ = kvso + (unsigned)(kb_) * (D * 2u); \
                           st_k0 = __builtin_bit_cast(bf16x8, __builtin_amdgcn_raw_buffer_load_b128(rK, voff0, so_, 0)); st_k1 = __builtin_bit_cast(bf16x8, __builtin_amdgcn_raw_buffer_load_b128(rK, voff1, so_, 0)); \
                           st_v0 = __builtin_bit_cast(bf16x8, __builtin_amdgcn_raw_buffer_load_b128(rV, voff0, so_, 0)); st_v1 = __builtin_bit_cast(bf16x8, __builtin_amdgcn_raw_buffer_load_b128(rV, voff1, so_, 0)); } while (0)
#define ATT_WRITE(kbf, vbf) do { *reinterpret_cast<LAS bf16x8*>(K_lds + (kbf) * SHM_K + kws) = st_k0; *reinterpret_cast<LAS bf16x8*>(K_lds + (kbf) * SHM_K + kws + 32 * 256) = st_k1; \
                           *reinterpret_cast<LAS bf16x8*>(V_lds + (vbf) * SHM_V + vst0) = st_v0; *reinterpret_cast<LAS bf16x8*>(V_lds + (vbf) * SHM_V + vst1) = st_v1; } while (0)
            __syncthreads();
            ATT_LOAD(ATT_KB(0)); ATT_WRITE(0, 0);
            bf16x8 pa0, pa1, pa2, pa3; bool pend = false; int vb = 0, vbp = 0;
            unsigned mw0 = 0u, mw1 = 0u;
            if (MODE == 1) { const v2u bw = __builtin_amdgcn_raw_buffer_load_b64(rB, boff, bso, 0); mw0 = bw.x; mw1 = bw.y; }
            __syncthreads();
            for (int t = 0; t < NT; ++t) {
                const int kb = ATT_KB(t), buf = t & 1;
                const bool more = t + 1 < NT;
                if (more) ATT_LOAD(ATT_KB(t + 1));
                unsigned nw0 = 0u, nw1 = 0u;
                if (MODE == 1 && more) { const v2u bw = __builtin_amdgcn_raw_buffer_load_b64(rB, boff, bso + (unsigned)((kb + KVBLK) >> 5) * 4u, 0); nw0 = bw.x; nw1 = bw.y; }
                if (late && pend) { pv_tile(o, vbase + vbp * SHM_V, pa0, pa1, pa2, pa3); pend = false; }
                const bool act = (MODE == 0) ? (kb < qlo + 31 && R_any_alive(R)) : (kb <= qlo + 31);
                if (act) {
                    f32x16 p0, p1;
                    qkt(p0, p1, K_lds + buf * SHM_K, r32, hi, qr);
                    if (MODE == 0) {
                        if (kb + KVBLK - 1 >= qlo) sb_tile<true>(p0, p1, R, qpos - kb - 4 * hi, hi); else sb_tile<false>(p0, p1, R, 0, hi);
                    } else {
                        const float NEG = -__builtin_inff();
                        const unsigned s0 = mw0 >> (4 * hi), s1 = mw1 >> (4 * hi);
#pragma unroll
                        for (int r = 0; r < 16; ++r) { const unsigned bit = 1u << ((r & 3) + 8 * (r >> 2)); p0[r] = (s0 & bit) ? p0[r] : NEG; p1[r] = (s1 & bit) ? p1[r] : NEG; }
                        float pmax = p0[0];
#pragma unroll
                        for (int r = 1; r < 16; ++r) pmax = fmaxf(pmax, p0[r]);
#pragma unroll
                        for (int r = 0; r < 16; ++r) pmax = fmaxf(pmax, p1[r]);
                        pmax = swap_max(pmax);
                        const float mn = fmaxf(m_reg, pmax), alpha = __builtin_amdgcn_exp2f(m_reg - mn); m_reg = mn;
                        float ps = 0.f;
#pragma unroll
                        for (int r = 0; r < 16; ++r) { p0[r] = __builtin_amdgcn_exp2f(p0[r] - mn); p1[r] = __builtin_amdgcn_exp2f(p1[r] - mn); ps += p0[r] + p1[r]; }
                        ps = swap_add(ps);
                        l_reg = l_reg * alpha + ps;
                        if (__any(alpha < 1.0f)) {
#pragma unroll
                            for (int d_ = 0; d_ < 4; ++d_) o[d_] *= alpha; }
                    }
                    ATT_PK4(p0, 0, pa0); ATT_PK4(p0, 8, pa1); ATT_PK4(p1, 0, pa2); ATT_PK4(p1, 8, pa3);
                    if (!late) pv_tile(o, vbase + vb * SHM_V, pa0, pa1, pa2, pa3); else { pend = true; vbp = vb; }
                }
                const int vbn = (vb == 2) ? 0 : vb + 1;
                if (more) ATT_WRITE(buf ^ 1, vbn);
                mw0 = nw0; mw1 = nw1;
                if (MODE == 0) { if (lane == 0) flags[buf * 8 + wid] = R_any_alive(R) ? 1u : 0u; }
                __syncthreads();
                if (MODE == 0) { unsigned alive = 0u;
#pragma unroll
                    for (int w = 0; w < 8; ++w) alive |= flags[buf * 8 + w];
                    if (alive == 0u) break; }
                vb = vbn;
            }
            if (late && pend) pv_tile(o, vbase + vbp * SHM_V, pa0, pa1, pa2, pa3);
            const unsigned oso = (unsigned)((b * S + qlo) * D + h * HD) * 2u;
            store_o_rows(o, (MODE == 1) ? __builtin_amdgcn_rcpf(l_reg) : 1.0f, rO, (unsigned)(r32 * D) * 2u + (unsigned)hi * 16u, oso);
#undef ATT_KB
#undef ATT_LOAD
#undef ATT_WRITE
        }
    }
}
__device__ __forceinline__ void dsa_mask(f32x16& p0, f32x16& p1, unsigned w0, unsigned w1, int hi) {
    const float NEG = -__builtin_inff(); const unsigned s0 = w0 >> (4 * hi), s1 = w1 >> (4 * hi);
#pragma unroll
    for (int r = 0; r < 16; ++r) { const unsigned bit = 1u << ((r & 3) + 8 * (r >> 2)); p0[r] = (s0 & bit) ? p0[r] : NEG; p1[r] = (s1 & bit) ? p1[r] : NEG; }
}
__device__ __forceinline__ void dsa_partial(f32x16& p0, f32x16& p1, float& m_reg, float& mn, float& alpha) {
    float pmax = p0[0];
#pragma unroll
    for (int r = 1; r < 16; ++r) pmax = fmaxf(pmax, p0[r]);
#pragma unroll
    for (int r = 0; r < 16; ++r) pmax = fmaxf(pmax, p1[r]);
    pmax = swap_max(pmax);
    if (__all(pmax - m_reg <= 8.0f)) { mn = m_reg; alpha = 1.0f; }
    else { mn = fmaxf(m_reg, pmax); alpha = __builtin_amdgcn_exp2f(m_reg - mn); m_reg = mn; }
#pragma unroll
    for (int r = 0; r < 16; ++r) p0[r] = __builtin_amdgcn_exp2f(p0[r] - mn);
}
__device__ __forceinline__ void dsa_finish(f32x16& p0, f32x16& p1, float mn, float alpha, float& l_reg, bf16x8& pa0, bf16x8& pa1, bf16x8& pa2, bf16x8& pa3) {
#pragma unroll
    for (int r = 0; r < 16; ++r) p1[r] = __builtin_amdgcn_exp2f(p1[r] - mn);
    float ps = 0.f;
#pragma unroll
    for (int r = 0; r < 16; ++r) ps += p0[r];
#pragma unroll
    for (int r = 0; r < 16; ++r) ps += p1[r];
    ps = swap_add(ps);
    l_reg = l_reg * alpha + ps;
    ATT_PK4(p0, 0, pa0); ATT_PK4(p0, 8, pa1); ATT_PK4(p1, 0, pa2); ATT_PK4(p1, 8, pa3);
}
__device__ __forceinline__ void attn_dsa_pipelined(const Ctx& X, const bf16* QN, const bf16* KN, const bf16* VN, const unsigned* BITS, bf16* O) {
    const int tid = X.tid, wid = X.wave, lane = X.lane, r32 = lane & 31, hi = lane >> 5;
    LAS char* lds = (LAS char*)(X.lds + RING_OFF);
    LAS char* V_lds = lds + OFF_V; LAS char* K_lds = lds + OFF_K;
    LAS float* wsl = (LAS float*)(lds + OFF_WS) + wid * 64;
    const int sr = tid >> 4, sc = (tid & 15) * 8, vst0 = v_st(sr, sc), vst1 = v_st(32 + sr, sc), kws = KSWZ(sr, sc * 2);
    const int vbase = (int)(uintptr_t)V_lds + v_rd_base(lane);
    const unsigned voff0 = (unsigned)(sr * D + sc) * 2u, voff1 = voff0 + 32u * D * 2u;
    const unsigned qoff = (unsigned)((wid * 32 + r32) * D + hi * 8) * 2u;
    const unsigned boff = (unsigned)(wid * 32 + r32) * 512u;
    const __amdgpu_buffer_rsrc_t rK = __builtin_amdgcn_make_buffer_rsrc((void*)KN, (short)0, M * D * 2, 0x00020000);
    const __amdgpu_buffer_rsrc_t rV = __builtin_amdgcn_make_buffer_rsrc((void*)VN, (short)0, M * D * 2, 0x00020000);
    const __amdgpu_buffer_rsrc_t rQ = __builtin_amdgcn_make_buffer_rsrc((void*)QN, (short)0, M * D * 2, 0x00020000);
    const __amdgpu_buffer_rsrc_t rO = __builtin_amdgcn_make_buffer_rsrc((void*)O, (short)0, M * D * 2, 0x00020000);
    const __amdgpu_buffer_rsrc_t rB = __builtin_amdgcn_make_buffer_rsrc((void*)BITS, (short)0, M * 128 * 4, 0x00020000);
    for (int slot = X.vcu; slot < 256; slot += X.G) {
        const int bh = slot >> 2, sub = slot & 3, b = bh >> 4, h = bh & 15;
        const unsigned kvso = (unsigned)((b * S) * D + h * HD) * 2u;
        for (int qi = 0; qi < 4; ++qi) {
            const int qb = (qi == 0) ? sub : (qi == 1) ? 7 - sub : (qi == 2) ? 8 + sub : 15 - sub;
            const int P0 = qb * 256, NT = P0 / KVBLK + 4;
            const int qlo = P0 + wid * 32;
            const unsigned qso = (unsigned)((b * S + P0) * D + h * HD) * 2u, bso = (unsigned)(b * S + P0) * 512u;
            bf16x8 qr[8];
#pragma unroll
            for (int d0 = 0; d0 < 8; ++d0) { const v4u q4 = __builtin_amdgcn_raw_buffer_load_b128(rQ, qoff + d0 * 32u, qso, 0); qr[d0] = __builtin_bit_cast(bf16x8, q4); }
            f32x16 o[4] = {};
            float m_reg = -1e30f, l_reg = 0.f;
            bf16x8 st_k0, st_k1, st_v0, st_v1; v2u mwn = {0u, 0u};
#define DSA_LOAD(t_) do { const unsigned so_ = kvso + (unsigned)((t_) * KVBLK) * (D * 2u); \
                          st_k0 = __builtin_bit_cast(bf16x8, __builtin_amdgcn_raw_buffer_load_b128(rK, voff0, so_, 0)); st_k1 = __builtin_bit_cast(bf16x8, __builtin_amdgcn_raw_buffer_load_b128(rK, voff1, so_, 0)); \
                          st_v0 = __builtin_bit_cast(bf16x8, __builtin_amdgcn_raw_buffer_load_b128(rV, voff0, so_, 0)); st_v1 = __builtin_bit_cast(bf16x8, __builtin_amdgcn_raw_buffer_load_b128(rV, voff1, so_, 0)); \
                          mwn = __builtin_amdgcn_raw_buffer_load_b64(rB, boff, bso + (unsigned)(t_) * 8u, 0); } while (0)
#define DSA_WRITE(bf) do { *reinterpret_cast<LAS bf16x8*>(K_lds + (bf) * SHM_K + kws) = st_k0; *reinterpret_cast<LAS bf16x8*>(K_lds + (bf) * SHM_K + kws + 32 * 256) = st_k1; \
                           *reinterpret_cast<LAS bf16x8*>(V_lds + (bf) * SHM_V + vst0) = st_v0; *reinterpret_cast<LAS bf16x8*>(V_lds + (bf) * SHM_V + vst1) = st_v1; } while (0)
#define DSA_ACT(t_) ((t_) * KVBLK <= qlo + 31)
#define DSA_RESC(a) do { if (__any((a) < 1.0f)) { _Pragma("unroll") for (int d_ = 0; d_ < 4; ++d_) o[d_] *= (a); } } while (0)
            f32x16 pA0, pA1, pB0, pB1; float mnA = 0.f, mnB = 0.f, alA = 1.f, alB = 1.f; bf16x8 pa0, pa1, pa2, pa3; unsigned mw0, mw1;
            __syncthreads();
            DSA_LOAD(0); DSA_WRITE(0); mw0 = mwn.x; mw1 = mwn.y;
            DSA_LOAD(1);
            __syncthreads();
            qkt(pA0, pA1, K_lds, r32, hi, qr);
            DSA_WRITE(1);
            dsa_mask(pA0, pA1, mw0, mw1, hi); dsa_partial(pA0, pA1, m_reg, mnA, alA);
            mw0 = mwn.x; mw1 = mwn.y;
            __syncthreads();
#define DSA_HALF(PX0, PX1, mnX, alX, PY0, PY1, mnY, alY, t_, KB, VB, SB_) do { \
                const bool actx = DSA_ACT(t_), acty = DSA_ACT((t_) - 1); \
                if (actx) qkt(PX0, PX1, K_lds + (KB) * SHM_K, r32, hi, qr); \
                if (acty) dsa_finish(PY0, PY1, mnY, alY, l_reg, pa0, pa1, pa2, pa3); \
                if ((t_) + 1 < NT) DSA_LOAD((t_) + 1); \
                if (acty) pv_tile(o, vbase + (VB) * SHM_V, pa0, pa1, pa2, pa3); \
                if (actx) { dsa_mask(PX0, PX1, mw0, mw1, hi); dsa_partial(PX0, PX1, m_reg, mnX, alX); } else { alX = 1.0f; } \
                mw0 = mwn.x; mw1 = mwn.y; \
                __syncthreads(); \
                if ((t_) + 1 < NT) DSA_WRITE(SB_); \
                if (actx) DSA_RESC(alX); \
                __syncthreads(); } while (0)
            for (int t = 1; t + 1 < NT; t += 2) {
                DSA_HALF(pB0, pB1, mnB, alB, pA0, pA1, mnA, alA, t, 1, 0, 0);
                DSA_HALF(pA0, pA1, mnA, alA, pB0, pB1, mnB, alB, t + 1, 0, 1, 1);
            }
            { const bool actx = DSA_ACT(NT - 1), acty = DSA_ACT(NT - 2);
              if (actx) qkt(pB0, pB1, K_lds + SHM_K, r32, hi, qr);
              if (acty) { dsa_finish(pA0, pA1, mnA, alA, l_reg, pa0, pa1, pa2, pa3); pv_tile(o, vbase, pa0, pa1, pa2, pa3); }
              if (actx) { dsa_mask(pB0, pB1, mw0, mw1, hi); dsa_partial(pB0, pB1, m_reg, mnB, alB); DSA_RESC(alB);
                          dsa_finish(pB0, pB1, mnB, alB, l_reg, pa0, pa1, pa2, pa3); pv_tile(o, vbase + SHM_V, pa0, pa1, pa2, pa3); } }
            const unsigned oso = (unsigned)((b * S + qlo) * D + h * HD) * 2u;
            store_o_rows(o, __builtin_amdgcn_rcpf(l_reg), rO, (unsigned)(r32 * D) * 2u + (unsigned)hi * 16u, oso);
#undef DSA_LOAD
#undef DSA_WRITE
#undef DSA_ACT
#undef DSA_RESC
#undef DSA_HALF
        }
    }
}
}
struct Args { const void* in[27]; float* out; unsigned char* ws; };
typedef const void* cvp_t;
__device__ __forceinline__ const void* karg(int i) {
    unsigned long long a = (unsigned long long)__builtin_amdgcn_kernarg_segment_ptr(); asm volatile("" : "+s"(a));
    return ((const __attribute__((address_space(4))) cvp_t*)a)[i];
}
enum { I_X = 0, I_C, I_POS, I_LN1G, I_LN2G, I_ADAW, I_ADAB, I_W1, I_W2, I_SBWIN, I_SBQG, I_SBKG, I_SBWOUT, I_S5WIN, I_S5LRE, I_S5LIM, I_S5LOGDT, I_S5BRE, I_S5BIM,
       I_S5CRE, I_S5CIM, I_S5D, I_S5WGLU, I_DSAWIN, I_DSAQG, I_DSAKG, I_DSAWOUT };

__global__ void __launch_bounds__(NWAVES * 64, 2) fwd_kernel(Args args) {
    extern __shared__ __attribute__((aligned(16))) unsigned char lds_raw[];
    Ctx X;
    X.lds = (LAS unsigned char*)lds_raw;
    X.tid = threadIdx.x; X.lane = X.tid & 63; X.wave = __builtin_amdgcn_readfirstlane(X.tid >> 6);
    X.G = gridDim.x; { const int bx = blockIdx.x; X.vcu = (X.G % 8 == 0) ? (bx % 8) * (X.G / 8) + bx / 8 : bx; }
    X.gw = X.vcu * NWAVES + X.wave; X.NGW = X.G * NWAVES;
    unsigned* ctl = (unsigned*)(args.ws + WS_CTL);
    for (int u = X.tid; u < (LDS_BYTES - LDSCTL_OFF) / 4; u += NWAVES * 64) ((LAS unsigned*)(X.lds + LDSCTL_OFF))[u] = 0u;
    __syncthreads();
    volatile LAS unsigned* MISC = (volatile LAS unsigned*)(X.lds + MISC_OFF);
    XcdBarrier bar = xcd_barrier_post(ctl + CW_BAR, MISC + 8);
#define GRID_BAR() do { XcdBarrier bb_ = bar; asm volatile("" : "+s"(bb_.x), "+s"(bb_.bar)); const Ctx xb_ = fresh(X); xcd_barrier(bb_, xb_.tid == 0); } while (0)

#define INF(i) ((const float*)karg(i))
#define WSP(T, off) ((T*)((unsigned char*)karg(28) + (off)))
#define XOUT ((float*)karg(27))
#define MOD WSP(float, WS_MOD)
#define S5C WSP(float, WS_S5C)
#define W1T WSP(bf16, WS_W1T)
#define W2T WSP(bf16, WS_W2T)
#define SBIN WSP(bf16, WS_SBIN)
#define SBOUT WSP(bf16, WS_SBOUT)
#define S5IN WSP(bf16, WS_S5IN)
#define S5GLU WSP(bf16, WS_S5GLU)
#define DSAIN WSP(bf16, WS_DSAIN)
#define DSAOUT WSP(bf16, WS_DSAOUT)
#define H WSP(bf16, WS_H)
#define BIG WSP(float, WS_BIG)
#define QN WSP(bf16, WS_QN)
#define KN WSP(bf16, WS_KN)
#define VN WSP(bf16, WS_VN)
#define OB WSP(bf16, WS_O)
#define QI WSP(bf16, WS_QI)
#define KI WSP(bf16, WS_KI)
#define WI WSP(float, WS_WI)
#define BITS WSP(unsigned, WS_BITS)
#define E5 WSP(float, WS_E)
#define AG WSP(bf16, WS_AG)
#define XH WSP(_Float16, WS_XH)
#define B1S WSP(bf16, WS_B1)
#define B3S WSP(bf16, WS_B3)
    LAS unsigned char* ring = X.lds + RING_OFF;

    _Pragma("unroll 1") for (int rpro_ = 0; rpro_ < REP_PRO; ++rpro_) {
    _Pragma("unroll 1") for (int rep_ = 0; rep_ < REP_MOD; ++rep_) ph_mod(fresh(X), INF(I_C), INF(I_ADAW), INF(I_ADAB), MOD);
    _Pragma("unroll 1") for (int rep_ = 0; rep_ < REP_S5PRE; ++rep_)
    ph_s5_pre(fresh(X), INF(I_S5LRE), INF(I_S5LIM), INF(I_S5LOGDT), INF(I_S5BRE), INF(I_S5BIM), INF(I_S5CRE), INF(I_S5CIM), S5C, B1S, B3S);
    int trot = 0;
    _Pragma("unroll 1") for (int rep_ = 0; rep_ < REP_TR; ++rep_) {
    for (int l = 0; l < NL - 1; ++l) {
        { const Ctx Y = fresh(X); tr_matrix(Y, INF(I_W1) + (size_t)l * D * FF, D, FF, FF, W1T + (size_t)l * FF * D, 0, trot, Y.gw, Y.NGW); }
        { const Ctx Y = fresh(X); tr_matrix(Y, INF(I_W2) + (size_t)l * FF * D, FF, D, D, W2T + (size_t)l * D * FF, 0, trot, Y.gw, Y.NGW); }
    }
    for (int j = 0; j < 2; ++j) {
        { const Ctx Y = fresh(X); tr_matrix(Y, INF(I_SBWIN) + (size_t)j * D * 3 * D, D, 3 * D, 3 * D, SBIN + (size_t)j * 3 * D * D, TR_QKV, trot, Y.gw, Y.NGW); }
        { const Ctx Y = fresh(X); tr_matrix(Y, INF(I_SBWOUT) + (size_t)j * D * D, D, D, D, SBOUT + (size_t)j * D * D, 0, trot, Y.gw, Y.NGW); }
    }
    { const Ctx Y = fresh(X); tr_matrix(Y, INF(I_S5WIN), D, D, D, S5IN, 0, trot, Y.gw, Y.NGW); }
    { const Ctx Y = fresh(X); tr_matrix(Y, INF(I_S5WGLU), D, 2 * D, 2 * D, S5GLU, TR_GLU, trot, Y.gw, Y.NGW); }
    { const Ctx Y = fresh(X); tr_matrix(Y, INF(I_DSAWIN), D, DSA_N, DSA_NP, DSAIN, TR_DSA, trot, Y.gw, Y.NGW); }
    ph_rope_tables(fresh(X), (const int*)karg(I_POS), WSP(float, WS_CS), WSP(float, WS_CS2));
    { const Ctx Y = fresh(X); tr_matrix(Y, INF(I_DSAWOUT), D, D, D, DSAOUT, 0, trot, Y.gw, Y.NGW); }
    }
    GRID_BAR();
    }

#define XCUR ((l == 0) ? INF(I_X) : (const float*)XOUT)
    for (int l = 0; l < NL; ++l) {
        const int kind = l % 3, jm = l / 3;
        _Pragma("unroll 1") for (int rep_ = 0; rep_ < REP_LN; ++rep_) { if (l == 0) ph_ln_mod(fresh(X), INF(I_X), INF(I_LN1G) + (size_t)l * D, (MOD + (size_t)l * NB * 6 * D), 0, D, H); else ph_ln_mod_h(fresh(X), XH, INF(I_LN1G) + (size_t)l * D, (MOD + (size_t)l * NB * 6 * D), 0, D, H); GRID_BAR(); }
        if (kind == 1) {
            pg8::Gemm g{H, S5IN, M, D, D}; pg8::StaticOrder So; So.init(M, D, X.G, (int)blockIdx.x, WGM_S5U);
            pg8::EpiS5U Ep{AG};
            _Pragma("unroll 1") for (int rep_ = 0; rep_ < REP_S5U; ++rep_) {
            pg8::gemm_phase<pg8::EpiS5U, pg8::StaticOrder, true, true>(ring, g, So, Ep, X.wave);
            GRID_BAR(); }
        } else {
            const bf16* Bt = kind == 0 ? SBIN + (size_t)jm * 3 * D * D : DSAIN;
            const int N = kind == 0 ? 3 * D : DSA_NP;
            pg8::Gemm g{H, Bt, M, N, D}; pg8::StaticOrder So; So.init(M, N, X.G, (int)blockIdx.x, WGM_QKV);
            pg8::EpiQkv Ep{QN, KN, VN, QI, KI, WI, kind == 0 ? INF(I_SBQG) + jm * HD : INF(I_DSAQG), kind == 0 ? INF(I_SBKG) + jm * HD : INF(I_DSAKG), WSP(float, WS_CS), WSP(float, WS_CS2), kind == 2 ? 1 : 0, QSCALE, EPS,
                           (PG8_LAS float*)(X.lds + EPI_OFF)};
            _Pragma("unroll 1") for (int rep_ = 0; rep_ < REP_QKV; ++rep_) {
            Ep.skip = (EPI_NULL && rep_ < REP_QKV - 1) ? 1 : 0;
            pg8::gemm_phase<pg8::EpiQkv, pg8::StaticOrder, true, true>(ring, g, So, Ep, X.wave);
            if (l == 2) {
                const int nun = (M / 256) * (DSA_NP / 256), rounds = (nun + X.G - 1) / X.G; int fi = nun - (rounds - 1) * X.G; if (fi >= X.G) fi = 0;
                if ((int)blockIdx.x >= fi) { int drot = 0; const Ctx Y = fresh(X); const int dgw = ((int)blockIdx.x - fi) * NWAVES + Y.wave, dn = (Y.G - fi) * NWAVES;
                    tr_matrix(Y, INF(I_W1) + (size_t)3 * D * FF, D, FF, FF, W1T + (size_t)3 * FF * D, 0, drot, dgw, dn);
                    tr_matrix(Y, INF(I_W2) + (size_t)3 * FF * D, FF, D, D, W2T + (size_t)3 * D * FF, 0, drot, dgw, dn);
                }
            }
            GRID_BAR(); }
        }
        if (kind == 0) {
            _Pragma("unroll 1") for (int rep_ = 0; rep_ < REP_ATT_SB; ++rep_) { att::attn_phase<0, SB_STAG>(fresh(X), QN, KN, VN, nullptr, OB); GRID_BAR(); }
        } else if (kind == 1) {
            { pg8::Gemm g{AG, B1S, G5 * 1024, 256, 256, 384, 256}; pg8::GroupOrder So{X.G, (int)blockIdx.x};
              pg8::EpiS5E Ep{E5};
              _Pragma("unroll 1") for (int rep_ = 0; rep_ < REP_S5A; ++rep_) {
              pg8::gemm_phase<pg8::EpiS5E, pg8::GroupOrder, true, true>(ring, g, So, Ep, X.wave); if (rep_ < REP_S5A - 1) GRID_BAR(); } }
            GRID_BAR();
            _Pragma("unroll 1") for (int rep_ = 0; rep_ < REP_CARRY; ++rep_) { ph_s5_carry(fresh(X), S5C, E5, AG);
            GRID_BAR(); }
            { pg8::Gemm g{AG, B3S, G5 * 1024, 256, 384, 384, 384}; pg8::GroupOrder So{X.G, (int)blockIdx.x};
              pg8::EpiS5Out Ep{__builtin_amdgcn_make_buffer_rsrc((void*)AG, (short)0, G5 * 1024 * 384 * 2, 0x00020000), __builtin_amdgcn_make_buffer_rsrc((void*)OB, (short)0, M * D * 2, 0x00020000), __builtin_amdgcn_make_buffer_rsrc((void*)INF(I_S5D), (short)0, D * 4, 0x00020000)};
              _Pragma("unroll 1") for (int rep_ = 0; rep_ < REP_S5B; ++rep_) {
              pg8::gemm_phase<pg8::EpiS5Out, pg8::GroupOrder, true, true>(ring, g, So, Ep, X.wave); if (rep_ < REP_S5B - 1) GRID_BAR(); } }
            GRID_BAR();
        } else {
            _Pragma("unroll 1") for (int rep_ = 0; rep_ < REP_IDX; ++rep_) { ph_idx_scores(fresh(X), QI, KI, WI, BIG); GRID_BAR(); }
            _Pragma("unroll 1") for (int rep_ = 0; rep_ < REP_SEL; ++rep_) { ph_topk_select(fresh(X), BIG, BITS); GRID_BAR(); }
            _Pragma("unroll 1") for (int rep_ = 0; rep_ < REP_ATT_DSA; ++rep_) {
#if DSA_VARIANT == 0
            att::attn_dsa_pipelined(fresh(X), QN, KN, VN, BITS, OB);
#elif DSA_VARIANT == 1
            att::attn_phase<1, true>(fresh(X), QN, KN, VN, BITS, OB);
#else
            att::attn_phase<1, false>(fresh(X), QN, KN, VN, BITS, OB);
#endif
            GRID_BAR(); }
        }
        if (kind == 1) {
            pg8::Gemm g{OB, S5GLU, M, 2 * D, D, 0, 0}; pg8::StaticOrder So; So.init(M, 2 * D, X.G, (int)blockIdx.x, WGM_GLU);
            _Pragma("unroll 1") for (int rep_ = 0; rep_ < REP_OUT; ++rep_) {
            pg8::EpiGluRes Ep{XH, rep_ == REP_OUT - 1 ? XH : WSP(_Float16, WS_QN), (MOD + (size_t)l * NB * 6 * D) + 2 * D, 6 * D};
            pg8::gemm_phase<pg8::EpiGluRes, pg8::StaticOrder, true, true, true>(ring, g, So, Ep, X.wave); if (rep_ < REP_OUT - 1) GRID_BAR(); }
        } else {
            const bf16* Bt = kind == 0 ? SBOUT + (size_t)jm * D * D : DSAOUT;
            pg8::Gemm g{OB, Bt, M, D, D}; pg8::StaticOrder So; So.init(M, D, X.G, (int)blockIdx.x, WGM_OUT);
            _Pragma("unroll 1") for (int rep_ = 0; rep_ < REP_OUT; ++rep_) {
            pg8::EpiRes Ep{l == 0 ? (const void*)INF(I_X) : (const void*)XH, rep_ == REP_OUT - 1 ? (void*)XH : (void*)WSP(_Float16, WS_QN), (MOD + (size_t)l * NB * 6 * D) + 2 * D, 6 * D, l == 0 ? 1 : 0, 0};
            pg8::gemm_phase<pg8::EpiRes, pg8::StaticOrder, true, true>(ring, g, So, Ep, X.wave); if (rep_ < REP_OUT - 1) GRID_BAR(); }
        }
        GRID_BAR();
        _Pragma("unroll 1") for (int rep_ = 0; rep_ < REP_LN; ++rep_) { ph_ln_mod_h(fresh(X), XH, INF(I_LN2G) + (size_t)l * D, (MOD + (size_t)l * NB * 6 * D), 3 * D, 4 * D, H); GRID_BAR(); }
        _Pragma("unroll 1") for (int rep_ = 0; rep_ < REP_MLP; ++rep_) {
#define XDST(fin) ((fin) ? (l == NL - 1 ? (void*)(XOUT + r0 * D) : (void*)(XH + r0 * D)) : (l == NL - 1 ? (void*)(WSP(float, WS_QN) + r0 * D) : (void*)(WSP(_Float16, WS_QN) + r0 * D)))
#if MLP_VARIANT >= 1
        _Pragma("unroll 1") for (int st = 0; st < 3; ++st) {
            const int first_up = (MLP_VARIANT == 2 && st == 1) ? ((int)blockIdx.x & 1) : 0;
            _Pragma("unroll 1") for (int sub = 0; sub < 2; ++sub) {
            if ((sub ^ first_up) == 0) { if (st > 0) {
                const int hf = st - 1; const size_t r0 = (size_t)hf * (M / 2);
                pg8::Gemm g{(const bf16*)BIG + (size_t)hf * (M / 2) * FF, W2T + (size_t)l * D * FF, M / 2, D, FF}; pg8::StaticOrder So; So.init(M / 2, D, X.G, (int)blockIdx.x, WGM_W2);
                pg8::EpiRes Ep{XH + r0 * D, XDST(rep_ == REP_MLP - 1), (MOD + (size_t)l * NB * 6 * D) + 5 * D + (size_t)hf * 2 * 6 * D, 6 * D, 0, l == NL - 1 ? 1 : 0};
                pg8::gemm_phase<pg8::EpiRes, pg8::StaticOrder, true, true>(ring, g, So, Ep, X.wave);
            } } else { if (st < 2) {
                const int hf = st; const size_t r0 = (size_t)hf * (M / 2);
                pg8::Gemm g{H + r0 * D, W1T + (size_t)l * FF * D, M / 2, FF, D}; pg8::StaticOrder So; So.init(M / 2, FF, X.G, (int)blockIdx.x, WGM_W1);
                pg8::EpiRelu2 Ep{(bf16*)BIG + (size_t)hf * (M / 2) * FF, FF};
                pg8::gemm_phase<pg8::EpiRelu2, pg8::StaticOrder, true, true>(ring, g, So, Ep, X.wave);
            } }
            if (sub == 0 && st == 1) { VM_WAIT(); __syncthreads(); }
            }
            if (l + 1 < NL || st < 2 || rep_ < REP_MLP - 1) GRID_BAR();
        }
#else
        _Pragma("unroll 1") for (int hf = 0; hf < 2; ++hf) {
            const size_t r0 = (size_t)hf * (M / 2);
            {
                pg8::Gemm g{H + r0 * D, W1T + (size_t)l * FF * D, M / 2, FF, D}; pg8::StaticOrder So; So.init(M / 2, FF, X.G, (int)blockIdx.x, WGM_W1);
                pg8::EpiRelu2 Ep{(bf16*)BIG, FF};
                _Pragma("unroll 1") for (int r2_ = 0; r2_ < REP_W1; ++r2_) {
                Ep.skip = (EPI_NULL && r2_ < REP_W1 - 1) ? 1 : 0;
                pg8::gemm_phase<pg8::EpiRelu2, pg8::StaticOrder, true, true>(ring, g, So, Ep, X.wave);
                GRID_BAR(); }
            }
            {
                pg8::Gemm g{(const bf16*)BIG, W2T + (size_t)l * D * FF, M / 2, D, FF}; pg8::StaticOrder So; So.init(M / 2, D, X.G, (int)blockIdx.x, WGM_W2);
                _Pragma("unroll 1") for (int r2_ = 0; r2_ < REP_W2; ++r2_) {
                pg8::EpiRes Ep{XH + r0 * D, XDST(rep_ == REP_MLP - 1 && r2_ == REP_W2 - 1), (MOD + (size_t)l * NB * 6 * D) + 5 * D + (size_t)hf * 2 * 6 * D, 6 * D, 0, l == NL - 1 ? 1 : 0};
                pg8::gemm_phase<pg8::EpiRes, pg8::StaticOrder, true, true>(ring, g, So, Ep, X.wave);
                if (l + 1 < NL || hf == 0 || rep_ < REP_MLP - 1 || r2_ < REP_W2 - 1) GRID_BAR(); }
            }
        }
#endif
        }
    }
    if (__hip_atomic_load(ctl + CW_BAR + XB_TMO, __ATOMIC_RELAXED, __HIP_MEMORY_SCOPE_AGENT) != 0u) {
        VM_WAIT(); __syncthreads();
        const float q = __builtin_nanf(""); const Ctx Xe = fresh(X);
        for (size_t i = (size_t)blockIdx.x * 512 + Xe.tid; i < (size_t)M * D; i += (size_t)X.G * 512) XOUT[i] = q;
    }
#undef GRID_BAR
}

extern "C" void kernel_launch(void* const* d_in, const int* in_sizes, int n_in, void* d_out, int out_size, void* d_ws, size_t ws_size, hipStream_t stream) {
    static int grid = 0;
    if (grid == 0) {
        if (n_in != 27 || in_sizes[0] != M * D || out_size != M * D || ws_size < WS_END) {
            fprintf(stderr, "kernel_launch: built for 27 inputs, x/out of %d floats, >= %zu bytes of workspace; got n_in %d, in0 %d, out %d, ws %zu; nothing launched\n", M * D, (size_t)WS_END, n_in, n_in > 0 ? in_sizes[0] : -1, out_size, ws_size);
            grid = -1; return; }
        int dev = 0, cus = 0, per_cu = 0;
        if (hipGetDevice(&dev) != hipSuccess || hipDeviceGetAttribute(&cus, hipDeviceAttributeMultiprocessorCount, dev) != hipSuccess) { fprintf(stderr, "kernel_launch: device query failed\n"); grid = -1; return; }
        if (hipFuncSetAttribute((const void*)fwd_kernel, hipFuncAttributeMaxDynamicSharedMemorySize, LDS_BYTES) != hipSuccess) { fprintf(stderr, "kernel_launch: hipFuncSetAttribute failed\n"); grid = -1; return; }
        if (hipOccupancyMaxActiveBlocksPerMultiprocessor(&per_cu, (const void*)fwd_kernel, NWAVES * 64, LDS_BYTES) != hipSuccess || per_cu < 1) {
            fprintf(stderr, "kernel_launch: occupancy query reports %d workgroups per CU for %d B of LDS; nothing launched\n", per_cu, LDS_BYTES); (void)hipGetLastError(); grid = -1; return; }
        grid = cus;
    }
    if (grid < 0) return;
    if (hipMemsetAsync((char*)d_ws + WS_CTL, 0, CTL_ZERO_BYTES, stream) != hipSuccess) { fprintf(stderr, "kernel_launch: memset failed\n"); return; }
    Args a{};
    for (int i = 0; i < 27; ++i) a.in[i] = d_in[i];
    a.out = (float*)d_out; a.ws = (unsigned char*)d_ws;
    hipLaunchKernelGGL(fwd_kernel, dim3(grid), dim3(NWAVES * 64), LDS_BYTES, stream, a);
    const hipError_t le = hipPeekAtLastError();
    if (le != hipSuccess) fprintf(stderr, "kernel_launch: launch failed: %s (grid %d)\n", hipGetErrorName(le), grid);
}
```

```cpp
#include <hip/hip_runtime.h>
#include <cstdio>
#include <cstdint>
#define WGM_QKV 4
#define WGM_S5U 4
#define WGM_OUT 4
#define WGM_GLU 4
#define WGM_W1 4
#define WGM_W2 4
#define REP_ATT_SB 1
#define REP_ATT_DSA 1
#define SB_STAG false
#define DSA_VARIANT 0
#define REP_LN 1
#define REP_IDX 1
#define REP_SEL 1
#define REP_CARRY 1
#define REP_MLP 1
#define MLP_VARIANT 1
#define REP_W1 1
#define REP_W2 1
#define REP_MOD 1
#define REP_TR 1
#define REP_PRO 1
#define REP_S5PRE 1
#define REP_QKV 1
#define EPI_NULL 0
#define REP_S5A 1
#define REP_S5B 1
#define REP_S5U 1
#define REP_OUT 1
namespace pg8 {
#define PG8_LAS __attribute__((address_space(3)))
typedef unsigned short bf16_t;
typedef short bf16x8 __attribute__((ext_vector_type(8)));
typedef float f32x4 __attribute__((ext_vector_type(4)));
typedef unsigned u32x4 __attribute__((ext_vector_type(4)));
constexpr int BM = 256, BK = 64, HALF = 128, HTB = HALF * BK * 2  , STAGE_BYTES = 8 * HTB, NXCD = 8, WGM = 4;

__host__ __device__ __forceinline__ int lds_byte(int r, int c) { const int st = (r >> 4) * 2 + (c >> 5), rr = r & 15, cc = c & 31, ob = rr * 64 + cc * 2; return st * 1024 + (ob ^ (((ob >> 9) & 1) << 5)); }
__host__ __device__ __forceinline__ void stage_rc(int b, int& R, int& C) { const int st = b / 1024, sb = b % 1024, swz = sb ^ (((sb >> 9) & 1) << 5); R = (st >> 1) * 16 + swz / 64; C = (st & 1) * 32 + (swz % 64) / 2; }
__host__ __device__ __forceinline__ int perm32(int rho) { const int n = rho >> 4, i = rho & 15; return 8 * (i >> 2) + 4 * n + (i & 3); }

struct Unit { int pm, pn; };
struct Gemm { const bf16_t* A; const bf16_t* Bt; int M, N, K; int lda, ldb; };

struct StaticOrder {
    int nM, nN, nwg, G, c, wgm;
    __host__ __device__ void init(int M, int N, int G_, int c_, int wgm_ = WGM) { nM = M / BM; nN = N / BM; nwg = nM * nN; G = G_; c = c_; wgm = wgm_; }
    __host__ __device__ bool next(int i, Unit& u) const {
        const long L = (long)i * G + c; if (L >= nwg) return false;
        int wgid = (int)L; { const int q = nwg / NXCD, r = nwg % NXCD, xcd = wgid % NXCD, off = wgid / NXCD; wgid = (xcd < r ? xcd * (q + 1) : r * (q + 1) + (xcd - r) * q) + off; }
        const int nig = wgm * nN, gid = wgid / nig, fm = gid * wgm, gsz = (nM - fm) < wgm ? (nM - fm) : wgm;
        u.pm = fm + ((wgid % nig) % gsz); u.pn = (wgid % nig) / gsz; return true;
    }
    __device__ __forceinline__ void a_ready(const Unit&) const {}
    __device__ __forceinline__ void done(const Unit&) const {}
};
__device__ __forceinline__ unsigned cvt_pk_bf16(float lo, float hi) { unsigned r; asm volatile("v_cvt_pk_bf16_f32 %0, %1, %2" : "=v"(r) : "v"(lo), "v"(hi)); return r; }
typedef float f32x2 __attribute__((ext_vector_type(2)));
typedef unsigned u32x2 __attribute__((ext_vector_type(2)));
struct EpiF32 {
    static constexpr bool PERM = false, AFTER_DRAIN = false;
    float* C; int ldc;
    __device__ __forceinline__ void operator()(const f32x4 (&acc)[2][2][4][2], const Unit& u, int wr, int wc, int fr, int fq) const {
        const int row0 = u.pm * BM + wr * 64 + fr, col0 = u.pn * BM + wc * 32 + 4 * fq;
#pragma unroll
        for (int ai = 0; ai < 2; ++ai)
#pragma unroll
            for (int m = 0; m < 4; ++m) { float* rowp = C + (size_t)(row0 + ai * HALF + m * 16) * ldc + col0;
#pragma unroll
                for (int bj = 0; bj < 2; ++bj)
#pragma unroll
                    for (int n = 0; n < 2; ++n) *(f32x4*)(rowp + bj * HALF + n * 16) = acc[ai][bj][m][n]; }
    }
};
typedef _Float16 h16x8 __attribute__((ext_vector_type(8)));
typedef _Float16 h16x4 __attribute__((ext_vector_type(4)));
struct EpiRes {
    static constexpr bool PERM = true, AFTER_DRAIN = false;
    const void* base; void* out; const float* gate; int gpitch; int in_f32, out_f32;
    __device__ __forceinline__ void operator()(const f32x4 (&acc)[2][2][4][2], const Unit& u, int wr, int wc, int fr, int fq) const {
        const int row0 = u.pm * BM + wr * 64 + fr, col0 = u.pn * BM + wc * 32 + 8 * fq;
        const float* gp = gate + (size_t)(u.pm >> 4) * gpitch + col0;
        f32x4 gv[2][2];
#pragma unroll
        for (int bj = 0; bj < 2; ++bj)
#pragma unroll
            for (int n = 0; n < 2; ++n) gv[bj][n] = *(const f32x4*)(gp + bj * HALF + n * 4);
#pragma unroll
        for (int ai = 0; ai < 2; ++ai)
#pragma unroll
            for (int m = 0; m < 4; ++m) { const size_t off = (size_t)(row0 + ai * HALF + m * 16) * 2048 + col0;
#pragma unroll
                for (int bj = 0; bj < 2; ++bj) { f32x4 b0, b1;
                    if (in_f32) { b0 = *(const f32x4*)((const float*)base + off + bj * HALF); b1 = *(const f32x4*)((const float*)base + off + bj * HALF + 4); }
                    else { const h16x8 hv = *(const h16x8*)((const _Float16*)base + off + bj * HALF);
                        b0 = (f32x4){(float)hv[0], (float)hv[1], (float)hv[2], (float)hv[3]}; b1 = (f32x4){(float)hv[4], (float)hv[5], (float)hv[6], (float)hv[7]}; }
                    const f32x4 r0 = b0 + gv[bj][0] * acc[ai][bj][m][0], r1 = b1 + gv[bj][1] * acc[ai][bj][m][1];
                    if (out_f32) { *(f32x4*)((float*)out + off + bj * HALF) = r0; *(f32x4*)((float*)out + off + bj * HALF + 4) = r1; }
                    else { h16x8 o; o[0] = (_Float16)r0[0]; o[1] = (_Float16)r0[1]; o[2] = (_Float16)r0[2]; o[3] = (_Float16)r0[3]; o[4] = (_Float16)r1[0]; o[5] = (_Float16)r1[1]; o[6] = (_Float16)r1[2]; o[7] = (_Float16)r1[3];
                        *(h16x8*)((_Float16*)out + off + bj * HALF) = o; } }
                if (m == 3) asm volatile("" ::: "memory"); }
    }
};
struct EpiRelu2 {
    static constexpr bool PERM = true, AFTER_DRAIN = false;
    bf16_t* O; int ldc; int skip = 0;
    __device__ __forceinline__ void operator()(const f32x4 (&acc)[2][2][4][2], const Unit& u, int wr, int wc, int fr, int fq) const {
        if (skip) return;
        const int row0 = u.pm * BM + wr * 64 + fr, col0 = u.pn * BM + wc * 32 + 8 * fq;
#pragma unroll
        for (int ai = 0; ai < 2; ++ai)
#pragma unroll
            for (int m = 0; m < 4; ++m) { bf16_t* rowp = O + (size_t)(row0 + ai * HALF + m * 16) * ldc + col0;
#pragma unroll
                for (int bj = 0; bj < 2; ++bj) { f32x4 v0 = acc[ai][bj][m][0], v1 = acc[ai][bj][m][1];
#pragma unroll
                    for (int j = 0; j < 4; ++j) { const float a = fmaxf(v0[j], 0.f), b = fmaxf(v1[j], 0.f); v0[j] = a * a; v1[j] = b * b; }
                    u32x4 w; w.x = cvt_pk_bf16(v0[0], v0[1]); w.y = cvt_pk_bf16(v0[2], v0[3]); w.z = cvt_pk_bf16(v1[0], v1[1]); w.w = cvt_pk_bf16(v1[2], v1[3]);
                    *(u32x4*)(rowp + bj * HALF) = w; } }
    }
};
struct EpiBf16Plain {
    static constexpr bool PERM = true, AFTER_DRAIN = false;
    bf16_t* O; int ldc;
    __device__ __forceinline__ void operator()(const f32x4 (&acc)[2][2][4][2], const Unit& u, int wr, int wc, int fr, int fq) const {
        const int row0 = u.pm * BM + wr * 64 + fr, col0 = u.pn * BM + wc * 32 + 8 * fq;
#pragma unroll
        for (int ai = 0; ai < 2; ++ai)
#pragma unroll
            for (int m = 0; m < 4; ++m) { bf16_t* rowp = O + (size_t)(row0 + ai * HALF + m * 16) * ldc + col0;
#pragma unroll
                for (int bj = 0; bj < 2; ++bj) { const f32x4 v0 = acc[ai][bj][m][0], v1 = acc[ai][bj][m][1];
                    u32x4 w; w.x = cvt_pk_bf16(v0[0], v0[1]); w.y = cvt_pk_bf16(v0[2], v0[3]); w.z = cvt_pk_bf16(v1[0], v1[1]); w.w = cvt_pk_bf16(v1[2], v1[3]);
                    *(u32x4*)(rowp + bj * HALF) = w; } }
    }
};
struct EpiGluRes {
    static constexpr bool PERM = false, AFTER_DRAIN = false;
    const _Float16* base; _Float16* out; const float* gate; int gpitch;
    __device__ __forceinline__ void operator()(const f32x4 (&acc)[2][2][4][2], const Unit& u, int wr, int wc, int fr, int fq) const {
        const int row0 = u.pm * BM + wr * 64 + fr, col0 = u.pn * HALF + wc * 32 + 4 * fq;
        const float* gp = gate + (size_t)(u.pm >> 4) * gpitch + col0;
        f32x4 gv[2];
#pragma unroll
        for (int n = 0; n < 2; ++n) gv[n] = *(const f32x4*)(gp + n * 16);
#pragma unroll
        for (int ai = 0; ai < 2; ++ai)
#pragma unroll
            for (int m = 0; m < 4; ++m) { const size_t off = (size_t)(row0 + ai * HALF + m * 16) * 2048 + col0;
#pragma unroll
                for (int n = 0; n < 2; ++n) { const h16x4 hv = *(const h16x4*)(base + off + n * 16); const f32x4 bs = {(float)hv[0], (float)hv[1], (float)hv[2], (float)hv[3]};
                    const f32x4 a = acc[ai][0][m][n], g = acc[ai][1][m][n]; f32x4 y;
#pragma unroll
                    for (int j = 0; j < 4; ++j) y[j] = a[j] * __builtin_amdgcn_rcpf(1.0f + __builtin_amdgcn_exp2f(-1.4426950408889634f * g[j]));
                    const f32x4 r = bs + gv[n] * y; h16x4 o; o[0] = (_Float16)r[0]; o[1] = (_Float16)r[1]; o[2] = (_Float16)r[2]; o[3] = (_Float16)r[3];
                    *(h16x4*)(out + off + n * 16) = o; }
                if (m == 3) asm volatile("" ::: "memory"); }
    }
};
struct GroupOrder {
    int G, c;
    __device__ __forceinline__ bool next(int i, Unit& u) const { const int L = i * G + c; if (L >= 512) return false; u.pm = L; u.pn = L >> 2; return true; }
    __device__ __forceinline__ void a_ready(const Unit&) const {}
    __device__ __forceinline__ void done(const Unit&) const {}
};
struct EpiS5U {
    static constexpr bool PERM = true, AFTER_DRAIN = false;
    bf16_t* AG;
    __device__ __forceinline__ void operator()(const f32x4 (&acc)[2][2][4][2], const Unit& u, int wr, int wc, int fr, int fq) const {
        const int row0 = u.pm * BM + wr * 64 + fr, col0 = u.pn * BM + wc * 32 + 8 * fq;
#pragma unroll
        for (int ai = 0; ai < 2; ++ai)
#pragma unroll
            for (int m = 0; m < 4; ++m) { const int row = row0 + ai * HALF + m * 16, rb = (row >> 12) * 256 + ((row & 4095) >> 4), tl = row & 15;
#pragma unroll
                for (int bj = 0; bj < 2; ++bj) { const int col = col0 + bj * HALF, g = col >> 4, c0 = col & 15; const f32x4 v0 = acc[ai][bj][m][0], v1 = acc[ai][bj][m][1];
                    u32x4 w; w.x = cvt_pk_bf16(v0[0], v0[1]); w.y = cvt_pk_bf16(v0[2], v0[3]); w.z = cvt_pk_bf16(v1[0], v1[1]); w.w = cvt_pk_bf16(v1[2], v1[3]);
                    *(u32x4*)(AG + ((size_t)(g * 1024 + rb) * 384 + tl * 16 + c0)) = w; } }
    }
};
struct EpiS5E {
    static constexpr bool PERM = false, AFTER_DRAIN = false;
    float* E;
    __device__ __forceinline__ void operator()(const f32x4 (&acc)[2][2][4][2], const Unit& u, int wr, int wc, int fr, int fq) const {
        const int row0 = u.pm * BM + wr * 64 + fr, col0 = wc * 32 + 4 * fq;
#pragma unroll
        for (int ai = 0; ai < 2; ++ai)
#pragma unroll
            for (int m = 0; m < 4; ++m) { float* rowp = E + (size_t)(row0 + ai * HALF + m * 16) * 128 + col0;
#pragma unroll
                for (int n = 0; n < 2; ++n) *(f32x4*)(rowp + n * 16) = acc[ai][0][m][n]; }
    }
};
struct EpiS5Out {
    static constexpr bool PERM = true, AFTER_DRAIN = false;
    __amdgpu_buffer_rsrc_t rAG, rZG, rD;
    __device__ __forceinline__ void operator()(const f32x4 (&acc)[2][2][4][2], const Unit& u, int wr, int wc, int, int) const {
        int ln; asm volatile("v_mbcnt_lo_u32_b32 %0, -1, 0\n\tv_mbcnt_hi_u32_b32 %0, -1, %0" : "=v"(ln));
        const int fr = ln & 15, fq = ln >> 4;
        const int col0 = wc * 32 + 8 * fq;
        const unsigned rowb = (unsigned)(u.pm * BM + wr * 64 + fr);
        const unsigned dof = (unsigned)(u.pn * 16 + 8 * (fq & 1)) * 4u;
        const f32x4 d0 = __builtin_bit_cast(f32x4, __builtin_amdgcn_raw_buffer_load_b128(rD, dof, 0, 0)), d1 = __builtin_bit_cast(f32x4, __builtin_amdgcn_raw_buffer_load_b128(rD, dof + 16u, 0, 0));
#pragma unroll
        for (int ai = 0; ai < 2; ++ai)
#pragma unroll
            for (int m = 0; m < 4; ++m) { const unsigned row = rowb + (unsigned)(ai * HALF + m * 16);
#pragma unroll
                for (int bj = 0; bj < 2; ++bj) { const int n0 = col0 + bj * HALF;
                    const u32x4 uv = __builtin_bit_cast(u32x4, __builtin_amdgcn_raw_buffer_load_b128(rAG, (row * 384u + (unsigned)n0) * 2u, 0, 0));
                    const unsigned ux = uv[0], uy = uv[1], uz = uv[2], uw = uv[3];
                    f32x4 y0 = acc[ai][bj][m][0], y1 = acc[ai][bj][m][1];
                    y0[0] += d0[0] * __builtin_bit_cast(float, ux << 16); y0[1] += d0[1] * __builtin_bit_cast(float, ux & 0xffff0000u);
                    y0[2] += d0[2] * __builtin_bit_cast(float, uy << 16); y0[3] += d0[3] * __builtin_bit_cast(float, uy & 0xffff0000u);
                    y1[0] += d1[0] * __builtin_bit_cast(float, uz << 16); y1[1] += d1[1] * __builtin_bit_cast(float, uz & 0xffff0000u);
                    y1[2] += d1[2] * __builtin_bit_cast(float, uw << 16); y1[3] += d1[3] * __builtin_bit_cast(float, uw & 0xffff0000u);
#pragma unroll
                    for (int j = 0; j < 4; ++j) {
                        { const float y = y0[j], a2 = 1.5957691216057308f * (y + 0.044715f * y * y * y); y0[j] = y * __builtin_amdgcn_rcpf(1.0f + __builtin_amdgcn_exp2f(-1.4426950408889634f * a2)); }
                        { const float y = y1[j], a2 = 1.5957691216057308f * (y + 0.044715f * y * y * y); y1[j] = y * __builtin_amdgcn_rcpf(1.0f + __builtin_amdgcn_exp2f(-1.4426950408889634f * a2)); } }
                    u32x4 w; w.x = cvt_pk_bf16(y0[0], y0[1]); w.y = cvt_pk_bf16(y0[2], y0[3]); w.z = cvt_pk_bf16(y1[0], y1[1]); w.w = cvt_pk_bf16(y1[2], y1[3]);
                    __builtin_amdgcn_raw_buffer_store_b128(w, rZG, (row * 256u + (unsigned)n0) * 2u, 0, 0); } }
    }
};
struct EpiQkv {
    static constexpr bool PERM = false, AFTER_DRAIN = false;
    bf16_t* QN; bf16_t* KN; bf16_t* VN; bf16_t* QI; bf16_t* KI; float* WI;
    const float* gq; const float* gk; const float* CS; const float* CS2; int dsa; float QS, eps;
    PG8_LAS float* P;
    int skip = 0;
    __device__ __forceinline__ static unsigned long long pk4(const f32x4 v) { return (unsigned long long)cvt_pk_bf16(v[0], v[1]) | ((unsigned long long)cvt_pk_bf16(v[2], v[3]) << 32); }
    __device__ __forceinline__ void operator()(const f32x4 (&acc)[2][2][4][2], const Unit& u, int wr, int wc, int fr, int fq) const {
        if (skip) return;
        const int row0 = u.pm * BM + wr * 64 + fr, lrow0 = wr * 64 + fr, sec = u.pn >> 3;
        if (sec < 2) {
            const int xidx = ((fr + 16 * fq) ^ 32) << 2;
#pragma unroll
            for (int ai = 0; ai < 2; ++ai)
#pragma unroll
                for (int m = 0; m < 4; ++m)
#pragma unroll
                    for (int bj = 0; bj < 2; ++bj) { const f32x4 a = acc[ai][bj][m][0], b = acc[ai][bj][m][1];
                        float ss = ((a[0] * a[0] + a[1] * a[1]) + (a[2] * a[2] + a[3] * a[3])) + ((b[0] * b[0] + b[1] * b[1]) + (b[2] * b[2] + b[3] * b[3]));
                        ss += __builtin_bit_cast(float, (unsigned)__builtin_amdgcn_ds_swizzle(__builtin_bit_cast(int, ss), (16 << 10) | 0x1F));
                        ss += __builtin_bit_cast(float, __builtin_amdgcn_ds_bpermute(xidx, __builtin_bit_cast(int, ss)));
                        if (fq == 0) P[((ai * HALF + lrow0 + m * 16) * 2 + bj) * 4 + wc] = ss; }
            asm volatile("s_waitcnt lgkmcnt(0)" ::: "memory"); __builtin_amdgcn_s_barrier(); asm volatile("" ::: "memory");
            int d0 = 16 * wc + 4 * fq; asm volatile("" : "+v"(d0));
            const float* gp = sec ? gk : gq;
            const f32x4 g0 = *(const f32x4*)(gp + d0), g1 = *(const f32x4*)(gp + 64 + d0);
            const f32x4 h0 = *(const f32x4*)(gp + 2 * d0), h1 = *(const f32x4*)(gp + 2 * d0 + 4);
            bf16_t* dst = (sec ? KN : QN) + (size_t)(u.pn & 7) * 256 + d0; const float qs = sec ? 1.0f : QS;
#pragma unroll
            for (int ai = 0; ai < 2; ++ai)
#pragma unroll
                for (int m = 0; m < 4; ++m) { const int lrow = ai * HALF + lrow0 + m * 16; const size_t row = (size_t)(row0 + ai * HALF + m * 16);
                    if (dsa) {
                        const f32x4 cs = *(const f32x4*)(CS + row * 128 + d0), sn = *(const f32x4*)(CS + row * 128 + 64 + d0);
#pragma unroll
                        for (int bj = 0; bj < 2; ++bj) { const f32x4 pp = *(const PG8_LAS f32x4*)(P + (lrow * 2 + bj) * 4);
                            const float r = qs * __builtin_amdgcn_rsqf(((pp[0] + pp[1]) + (pp[2] + pp[3])) * (1.0f / 128.0f) + eps);
                            const f32x4 y0 = acc[ai][bj][m][0] * r * g0, y1 = acc[ai][bj][m][1] * r * g1;
                            const f32x4 o0 = y0 * cs - y1 * sn, o1 = y1 * cs + y0 * sn;
                            bf16_t* dp = dst + row * 2048 + bj * 128;
                            *(unsigned long long*)dp = pk4(o0); *(unsigned long long*)(dp + 64) = pk4(o1); }
                    } else {
#pragma unroll
                        for (int bj = 0; bj < 2; ++bj) { const f32x4 pp = *(const PG8_LAS f32x4*)(P + (lrow * 2 + bj) * 4);
                            const float r = qs * __builtin_amdgcn_rsqf(((pp[0] + pp[1]) + (pp[2] + pp[3])) * (1.0f / 128.0f) + eps);
                            const f32x4 y0 = acc[ai][bj][m][0] * r * h0, y1 = acc[ai][bj][m][1] * r * h1;
                            u32x4 w; w.x = cvt_pk_bf16(y0[0], y0[1]); w.y = cvt_pk_bf16(y0[2], y0[3]); w.z = cvt_pk_bf16(y1[0], y1[1]); w.w = cvt_pk_bf16(y1[2], y1[3]);
                            *(u32x4*)(dst + d0 + row * 2048 + bj * 128) = w; }
                    } }
        } else if (sec == 2) {
            bf16_t* dst = VN + (size_t)(u.pn & 7) * 256 + 32 * wc + 8 * fq;
#pragma unroll
            for (int ai = 0; ai < 2; ++ai)
#pragma unroll
                for (int m = 0; m < 4; ++m) { const size_t row = (size_t)(row0 + ai * HALF + m * 16);
#pragma unroll
                    for (int bj = 0; bj < 2; ++bj) { const f32x4 v0 = acc[ai][bj][m][0], v1 = acc[ai][bj][m][1];
                        u32x4 w; w.x = cvt_pk_bf16(v0[0], v0[1]); w.y = cvt_pk_bf16(v0[2], v0[3]); w.z = cvt_pk_bf16(v1[0], v1[1]); w.w = cvt_pk_bf16(v1[2], v1[3]);
                        *(u32x4*)(dst + row * 2048 + bj * 128) = w; } }
        } else if (u.pn < 28) {
            const int d0 = 16 * (wc & 1) + 4 * fq;
#pragma unroll
            for (int ai = 0; ai < 2; ++ai)
#pragma unroll
                for (int m = 0; m < 4; ++m) { const size_t row = (size_t)(row0 + ai * HALF + m * 16);
                    const f32x4 cs = *(const f32x4*)(CS2 + row * 64 + d0), sn = *(const f32x4*)(CS2 + row * 64 + 32 + d0);
#pragma unroll
                    for (int bj = 0; bj < 2; ++bj) { const f32x4 y0 = acc[ai][bj][m][0], y1 = acc[ai][bj][m][1];
                        const f32x4 o0 = y0 * cs - y1 * sn, o1 = y1 * cs + y0 * sn;
                        bf16_t* dp = QI + row * 1024 + (size_t)((2 * (u.pn - 24) + bj) * 2 + (wc >> 1)) * 64 + d0;
                        *(unsigned long long*)dp = pk4(o0); *(unsigned long long*)(dp + 32) = pk4(o1); } }
        } else {
            const int d0 = 16 * (wc & 1) + 4 * fq;
#pragma unroll
            for (int ai = 0; ai < 2; ++ai)
#pragma unroll
                for (int m = 0; m < 4; ++m) { const size_t row = (size_t)(row0 + ai * HALF + m * 16);
                    if (wc < 2) { const f32x4 cs = *(const f32x4*)(CS2 + row * 64 + d0), sn = *(const f32x4*)(CS2 + row * 64 + 32 + d0);
                        const f32x4 y0 = acc[ai][0][m][0], y1 = acc[ai][0][m][1]; const f32x4 o0 = y0 * cs - y1 * sn, o1 = y1 * cs + y0 * sn;
                        bf16_t* dp = KI + row * 64 + d0; *(unsigned long long*)dp = pk4(o0); *(unsigned long long*)(dp + 32) = pk4(o1); }
                    else if (wc == 2) *(f32x4*)(WI + row * 16 + 4 * fq) = acc[ai][0][m][0] * (0.25f * 0.125f); }
        }
    }
};
template <class Epi, class Sched, bool ALIGN_EPI = false, bool SP2 = false, bool AGRP = false  >
__device__ __forceinline__ void gemm_phase(PG8_LAS unsigned char* lds, const Gemm g, const Sched& S, const Epi& E, int wid_in  ) {
    int lane_; asm volatile("v_mbcnt_lo_u32_b32 %0, -1, 0\n\tv_mbcnt_hi_u32_b32 %0, -1, %0" : "=v"(lane_));
    const int wid = wid_in, tid = wid * 64 + lane_, lane = lane_, wr = wid >> 2, wc = wid & 3, fr = lane & 15, fq = lane >> 4;
    const int K = g.K, nt = K / BK, lda = g.lda ? g.lda : K, ldb = g.ldb ? g.ldb : K;
    unsigned voffA[2], voffB[2];
#pragma unroll
    for (int i = 0; i < 2; ++i) { int R, C; stage_rc(tid * 16 + i * 8192, R, C); const int Rb = Epi::PERM ? ((R & ~31) + perm32(R & 31)) : R;
        voffA[i] = AGRP ? (unsigned)((C >> 4) * (g.M * 16) + R * 16 + (C & 15)) * 2u : (unsigned)(R * lda + C) * 2u; voffB[i] = (unsigned)(Rb * ldb + C) * 2u; }
    const size_t kstepA = AGRP ? (size_t)4 * g.M * 16 * 2 : (size_t)(BK * 2), kstepB = (size_t)(BK * 2);
    const size_t hstepA = AGRP ? (size_t)HALF * 16 * 2 : (size_t)HALF * lda * 2, hstepB = (size_t)HALF * ldb * 2;
    const size_t tstepA = 2 * hstepA, tstepB = 2 * hstepB;
    const unsigned ldsw = (unsigned)wid * 1024u;
    const int aoff = lds_byte(wr * 64 + fr, fq * 8), boff = lds_byte(wc * 32 + fr, fq * 8);
#define PG8_SA(b, h) (((b) * 2 + (h)) * HTB)
#define PG8_SB(b, h) ((4 + (b) * 2 + (h)) * HTB)
#define PG8_STAGE(bufoff, gbase, voff) do { _Pragma("unroll") for (int _i = 0; _i < 2; ++_i) \
        __builtin_amdgcn_global_load_lds((const unsigned*)((const char*)(gbase) + (voff)[_i]), (PG8_LAS unsigned*)(lds + (bufoff) + ldsw + _i * 8192), 16, 0, 0); } while (0)
#define PG8_LDA(dst, b, h) do { _Pragma("unroll") for (int m = 0; m < 4; ++m) _Pragma("unroll") for (int k = 0; k < 2; ++k) dst[m][k] = *(const PG8_LAS bf16x8*)(lds + PG8_SA(b, h) + aoff + m * 2048 + k * 1024); } while (0)
#define PG8_LDB(dst, b, h) do { _Pragma("unroll") for (int n = 0; n < 2; ++n) _Pragma("unroll") for (int k = 0; k < 2; ++k) dst[n][k] = *(const PG8_LAS bf16x8*)(lds + PG8_SB(b, h) + boff + n * 2048 + k * 1024); } while (0)
#define PG8_MMA(ai, bj, At, Bt) do { __builtin_amdgcn_s_setprio(1); _Pragma("unroll") for (int m = 0; m < 4; ++m) _Pragma("unroll") for (int n = 0; n < 2; ++n) _Pragma("unroll") for (int k = 0; k < 2; ++k) \
        acc[ai][bj][m][n] = __builtin_amdgcn_mfma_f32_16x16x32_bf16(Bt[n][k], At[m][k], acc[ai][bj][m][n], 0, 0, 0); __builtin_amdgcn_s_setprio(0); } while (0)
#define PG8_WAIT_V(n) asm volatile("s_waitcnt vmcnt(" #n ")" ::: "memory")
#define PG8_WAIT_L(n) asm volatile("s_waitcnt lgkmcnt(" #n ")" ::: "memory")
#define PG8_BAR __builtin_amdgcn_s_barrier()
#define PG8_SCHED __builtin_amdgcn_sched_barrier(0)
    Unit cur, nxt; int ui = 0;
    if (!S.next(0, cur)) return;
    f32x4 acc[2][2][4][2];
#pragma unroll
    for (int a = 0; a < 2; ++a)
#pragma unroll
        for (int b = 0; b < 2; ++b)
#pragma unroll
            for (int m = 0; m < 4; ++m)
#pragma unroll
                for (int n = 0; n < 2; ++n) acc[a][b][m][n] = (f32x4){0.f, 0.f, 0.f, 0.f};
    bf16x8 At[4][2], B0[2][2], B1[2][2];
    const char* cA = (const char*)g.A + (size_t)cur.pm * tstepA; const char* cB = (const char*)g.Bt + (size_t)cur.pn * tstepB;
    S.a_ready(cur);
    if constexpr (SP2) {
        PG8_STAGE(PG8_SB(0, 0), cB, voffB); PG8_STAGE(PG8_SB(0, 1), cB + hstepB, voffB); PG8_STAGE(PG8_SA(0, 0), cA, voffA); PG8_STAGE(PG8_SA(0, 1), cA + hstepA, voffA);
        if (wr == 1) PG8_BAR;
        PG8_WAIT_V(2); PG8_BAR;
        PG8_STAGE(PG8_SB(1, 0), cB + kstepB, voffB); PG8_STAGE(PG8_SA(1, 0), cA + kstepA, voffA); PG8_STAGE(PG8_SB(1, 1), cB + hstepB + kstepB, voffB);
        PG8_WAIT_V(6); PG8_BAR;
    } else {
        PG8_STAGE(PG8_SB(0, 0), cB, voffB); PG8_STAGE(PG8_SA(0, 0), cA, voffA); PG8_STAGE(PG8_SB(0, 1), cB + hstepB, voffB); PG8_STAGE(PG8_SA(0, 1), cA + hstepA, voffA);
        if (wr == 1) PG8_BAR;
        PG8_WAIT_V(4); PG8_BAR;
        PG8_STAGE(PG8_SB(1, 0), cB + kstepB, voffB); PG8_STAGE(PG8_SA(1, 0), cA + kstepA, voffA); PG8_STAGE(PG8_SB(1, 1), cB + hstepB + kstepB, voffB);
        PG8_WAIT_V(6); PG8_BAR;
    }
    for (;;) {
        const bool has_next = S.next(ui + 1, nxt);
        const char* nA = has_next ? (const char*)g.A + (size_t)nxt.pm * tstepA : cA; const char* nB = has_next ? (const char*)g.Bt + (size_t)nxt.pn * tstepB : cB;
        for (int t = 0; t < nt; t += 2) {
            const bool last = (t == nt - 2);
            const char* a1 = cA + (size_t)(t + 1) * kstepA;
            const char* a2 = last ? nA : cA + (size_t)(t + 2) * kstepA; const char* b2 = last ? nB : cB + (size_t)(t + 2) * kstepB;
            const char* a3 = a2 + kstepA; const char* b3 = b2 + kstepB;
            if (last && has_next) S.a_ready(nxt);
            if constexpr (SP2) {
            PG8_LDB(B0, 0, 0); PG8_LDB(B1, 0, 1); PG8_SCHED; PG8_LDA(At, 0, 0); PG8_STAGE(PG8_SA(1, 1), a1 + hstepA, voffA);
            PG8_WAIT_V(8); PG8_WAIT_L(0); PG8_BAR; PG8_MMA(0, 0, At, B0); PG8_MMA(0, 1, At, B1); PG8_BAR; PG8_SCHED;
            PG8_LDA(At, 0, 1); PG8_STAGE(PG8_SB(0, 0), b2, voffB); PG8_STAGE(PG8_SB(0, 1), b2 + hstepB, voffB); PG8_STAGE(PG8_SA(0, 0), a2, voffA);
            PG8_WAIT_V(8); PG8_WAIT_L(0); PG8_BAR; PG8_MMA(1, 0, At, B0); PG8_MMA(1, 1, At, B1); PG8_BAR; PG8_SCHED;
            PG8_LDB(B0, 1, 0); PG8_LDB(B1, 1, 1); PG8_SCHED; PG8_LDA(At, 1, 0); PG8_STAGE(PG8_SA(0, 1), a2 + hstepA, voffA);
            PG8_WAIT_V(8); PG8_WAIT_L(0); PG8_BAR; PG8_MMA(0, 0, At, B0); PG8_MMA(0, 1, At, B1); PG8_BAR; PG8_SCHED;
            PG8_LDA(At, 1, 1); PG8_STAGE(PG8_SB(1, 0), b3, voffB); PG8_STAGE(PG8_SB(1, 1), b3 + hstepB, voffB); PG8_STAGE(PG8_SA(1, 0), a3, voffA);
            PG8_WAIT_V(8); PG8_WAIT_L(0); PG8_BAR; PG8_MMA(1, 0, At, B0); PG8_MMA(1, 1, At, B1); PG8_BAR; PG8_SCHED;
            } else {
            PG8_LDB(B0, 0, 0); PG8_SCHED; PG8_LDA(At, 0, 0); PG8_STAGE(PG8_SA(1, 1), a1 + hstepA, voffA);
            PG8_WAIT_L(8); PG8_BAR; PG8_WAIT_L(0); PG8_MMA(0, 0, At, B0); PG8_BAR; PG8_SCHED;
            PG8_LDB(B1, 0, 1); PG8_STAGE(PG8_SB(0, 0), b2, voffB);
            PG8_BAR; PG8_WAIT_L(0); PG8_MMA(0, 1, At, B1); PG8_BAR;
            PG8_LDA(At, 0, 1); PG8_STAGE(PG8_SA(0, 0), a2, voffA);
            PG8_BAR; PG8_WAIT_L(0); PG8_MMA(1, 0, At, B0); PG8_BAR; PG8_SCHED;
            PG8_STAGE(PG8_SB(0, 1), b2 + hstepB, voffB);
            PG8_WAIT_V(6); PG8_BAR; PG8_MMA(1, 1, At, B1); PG8_BAR;
            PG8_LDB(B0, 1, 0); PG8_SCHED; PG8_LDA(At, 1, 0); PG8_STAGE(PG8_SA(0, 1), a2 + hstepA, voffA);
            PG8_WAIT_L(8); PG8_BAR; PG8_WAIT_L(0); PG8_MMA(0, 0, At, B0); PG8_BAR; PG8_SCHED;
            PG8_LDB(B1, 1, 1); PG8_STAGE(PG8_SB(1, 0), b3, voffB);
            PG8_BAR; PG8_WAIT_L(0); PG8_MMA(0, 1, At, B1); PG8_BAR;
            PG8_LDA(At, 1, 1); PG8_STAGE(PG8_SA(1, 0), a3, voffA);
            PG8_BAR; PG8_WAIT_L(0); PG8_MMA(1, 0, At, B0); PG8_BAR; PG8_SCHED;
            PG8_STAGE(PG8_SB(1, 1), b3 + hstepB, voffB);
            PG8_WAIT_V(6); PG8_BAR; PG8_MMA(1, 1, At, B1); PG8_BAR;
            }
        }
        if constexpr (ALIGN_EPI) { if (wr == 0) PG8_BAR; }
        if constexpr (!Epi::AFTER_DRAIN) { E(acc, cur, wr, wc, fr, fq); S.done(cur); }
        if (!has_next) break;
#pragma unroll
        for (int a = 0; a < 2; ++a)
#pragma unroll
            for (int b = 0; b < 2; ++b)
#pragma unroll
                for (int m = 0; m < 4; ++m)
#pragma unroll
                    for (int n = 0; n < 2; ++n) acc[a][b][m][n] = (f32x4){0.f, 0.f, 0.f, 0.f};
        cur = nxt; cA = nA; cB = nB; ++ui;
        if constexpr (ALIGN_EPI) { if (wr == 1) PG8_BAR; }
    }
    PG8_WAIT_V(0);
    if constexpr (!ALIGN_EPI) { if (wr == 0) PG8_BAR; }
    PG8_BAR;
    if constexpr (Epi::AFTER_DRAIN) { E.fused(acc, cur, wr, wc, fr, fq, lds, wid, lane); S.done(cur); }
#undef PG8_SA
#undef PG8_SB
#undef PG8_STAGE
#undef PG8_LDA
#undef PG8_LDB
#undef PG8_MMA
#undef PG8_WAIT_V
#undef PG8_WAIT_L
#undef PG8_BAR
#undef PG8_SCHED
}
}
constexpr int NB = 4, S = 4096, D = 2048, M = NB * S, FF = 8192, NH = 16, HD = 128, NL = 4;
constexpr int G5 = 128, P5 = 64, C5 = 16;
constexpr int DSA_N = 7248, DSA_NP = 7424, TOPK = 256;
constexpr float EPS = 1e-6f;
constexpr float QSCALE = 0.08838834764831845f * 1.4426950408889634f;
constexpr int NWAVES = 8;

constexpr size_t MiB = 1u << 20;
constexpr size_t WS_CTL = 0, CTL_ZERO_BYTES = 1 * MiB;
constexpr size_t WS_MOD = 2 * MiB;
constexpr size_t WS_S5C = 3 * MiB;
constexpr size_t WS_W1T = 8 * MiB;
constexpr size_t WS_W2T = WS_W1T + 128 * MiB;
constexpr size_t WS_SBIN = WS_W2T + 128 * MiB;
constexpr size_t WS_SBOUT = WS_SBIN + 48 * MiB;
constexpr size_t WS_S5IN = WS_SBOUT + 16 * MiB;
constexpr size_t WS_S5GLU = WS_S5IN + 8 * MiB;
constexpr size_t WS_DSAIN = WS_S5GLU + 16 * MiB;
constexpr size_t WS_DSAOUT = WS_DSAIN + 29 * MiB;
constexpr size_t WS_H = WS_DSAOUT + 8 * MiB + 3 * MiB;
constexpr size_t WS_BIG = WS_H + 64 * MiB;
constexpr size_t WS_QN = WS_BIG + 464 * MiB, WS_KN = WS_QN + 64 * MiB, WS_VN = WS_KN + 64 * MiB, WS_O = WS_VN + 64 * MiB;
constexpr size_t WS_QI = WS_O + 64 * MiB;
constexpr size_t WS_CS = WS_QI + 32 * MiB, WS_CS2 = WS_QI + 40 * MiB;
constexpr size_t WS_KI = WS_QI + 64 * MiB;
constexpr size_t WS_WI = WS_KI + 4 * MiB;
constexpr size_t WS_BITS = WS_WI + 1 * MiB;
constexpr size_t WS_B1 = WS_BITS + 8 * MiB;
constexpr size_t WS_B3 = WS_B1 + 16 * MiB;
constexpr size_t WS_END = WS_B3 + 24 * MiB;
constexpr size_t WS_AG = WS_BIG;
constexpr size_t WS_XH = WS_BIG + 384 * MiB;
constexpr size_t WS_E = WS_BIG + 96 * MiB;
static_assert((size_t)DSA_NP * D * 2 == 29 * MiB && (size_t)M * DSA_NP * 4 == 464 * MiB, "ws map");
constexpr int CW_TMO = 0, CW_BAR = 4096;

constexpr int RING_OFF = 0, RING_BYTES = 131072;
constexpr int LDSCTL_OFF = RING_BYTES, MISC_OFF = LDSCTL_OFF + 320;
constexpr int EPI_OFF = RING_BYTES + 512;
constexpr int LDS_BYTES = 147456;

#define GAS __attribute__((address_space(1)))
#define LAS __attribute__((address_space(3)))
typedef unsigned short bf16;
typedef unsigned v4u __attribute__((ext_vector_type(4)));
typedef unsigned v2u __attribute__((ext_vector_type(2)));
typedef float f32x4 __attribute__((ext_vector_type(4)));
typedef float f32x2v __attribute__((ext_vector_type(2)));
#define LDS_WAIT() asm volatile("s_waitcnt lgkmcnt(0)" ::: "memory")
#define VM_WAIT() asm volatile("s_waitcnt vmcnt(0)" ::: "memory")
__device__ __forceinline__ unsigned f2bf(float f) { unsigned u = __builtin_bit_cast(unsigned, f); return (u + 0x7fffu + ((u >> 16) & 1u)) >> 16; }
__device__ __forceinline__ unsigned pk2(float lo, float hi) { return f2bf(lo) | (f2bf(hi) << 16); }
__device__ __forceinline__ float bflo(unsigned u) { return __builtin_bit_cast(float, u << 16); }
__device__ __forceinline__ float bfhi(unsigned u) { return __builtin_bit_cast(float, u & 0xffff0000u); }
#define XB_TMO      128
#define XB_XCNT(j)  (256  + 64 * (j))
#define XB_XSUB(j)  (1280 + 64 * (j))
#define XB_XGEN(j)  (2304 + 64 * (j))
#define XB_TOP      3328
#define XB_TOPGEN   3392
#define XCD_BAR_WORDS 3456
#define XB_SPIN_CAP (1u << 18)

__device__ __forceinline__ unsigned xb_ld(unsigned* p)              { return __hip_atomic_load(p, __ATOMIC_RELAXED, __HIP_MEMORY_SCOPE_AGENT); }
__device__ __forceinline__ unsigned xb_add(unsigned* p, unsigned v) { return __hip_atomic_fetch_add(p, v, __ATOMIC_RELAXED, __HIP_MEMORY_SCOPE_AGENT); }
__device__ __forceinline__ unsigned xb_xcc_id() { return (unsigned)__builtin_amdgcn_s_getreg((3 << 11) | 20) & 0xFu; }
#define XB_SPIN(cond, bar) do { unsigned _sp = 0; while (cond) { __builtin_amdgcn_s_sleep(1); \
    if ((++_sp & 255u) == 0u) { if (xb_ld(&(bar)[XB_TMO])) break; if (_sp > XB_SPIN_CAP) { atomicAdd(&(bar)[XB_TMO], 1u); break; } } } } while (0)

struct XcdBarrier {
    unsigned* bar; unsigned x;
    volatile LAS unsigned* st;
};

__device__ __forceinline__ XcdBarrier xcd_barrier_post(unsigned* bar, volatile LAS unsigned* st) {
    XcdBarrier b; b.bar = bar; b.x = xb_xcc_id(); b.st = st;
    if (threadIdx.x == 0) (void)xb_add(&bar[XB_XCNT(b.x)], 1u);
    return b;
}
__device__ __forceinline__ void xcd_barrier_complete(unsigned* bar, unsigned x, unsigned& nloc, unsigned& nx) {
    const unsigned G = gridDim.x * gridDim.y * gridDim.z;
    unsigned sum, cnt, mine, sp = 0u;
    for (;;) {
        sum = 0u; cnt = 0u; mine = 0u;
#pragma unroll
        for (unsigned j = 0; j < 16; ++j) { const unsigned c = xb_ld(&bar[XB_XCNT(j)]); sum += c; cnt += (c > 0u) ? 1u : 0u; mine = (j == x) ? c : mine; }
        if (sum == G) break;
        __builtin_amdgcn_s_sleep(1);
        if ((++sp & 255u) == 0u) { if (xb_ld(&bar[XB_TMO])) break; if (sp > XB_SPIN_CAP) { atomicAdd(&bar[XB_TMO], 1u); break; } }
    }
    nloc = mine > 0u ? mine : 1u; nx = cnt > 0u ? cnt : 1u;
}

__device__ __forceinline__ void xcd_barrier(const XcdBarrier& b, const bool is_t0  ) {
    asm volatile("s_waitcnt vmcnt(0)" ::: "memory");
    __syncthreads();
    if (is_t0) {
        unsigned* bar = b.bar;
        __builtin_amdgcn_s_waitcnt(0);
        unsigned nloc = b.st[0], nx = b.st[1];
        if (nloc == 0u) { xcd_barrier_complete(bar, b.x, nloc, nx); b.st[0] = nloc; b.st[1] = nx; }
        const unsigned old = xb_add(&bar[XB_XSUB(b.x)], 1u);
        const unsigned gen = old / nloc;
        if (old + 1u == (gen + 1u) * nloc) {
            __builtin_amdgcn_fence(__ATOMIC_RELEASE, "agent");
            asm volatile("s_waitcnt vmcnt(0)" ::: "memory");
            const unsigned og = xb_add(&bar[XB_TOP], 1u);
            const unsigned tg = og / nx;
            if (og + 1u == (tg + 1u) * nx) xb_add(&bar[XB_TOPGEN], 1u);
            else XB_SPIN(xb_ld(&bar[XB_TOPGEN]) == tg, bar);
            __builtin_amdgcn_fence(__ATOMIC_ACQUIRE, "agent");
            xb_add(&bar[XB_XGEN(b.x)], 1u);
            asm volatile("s_waitcnt vmcnt(0)" ::: "memory");
        } else {
            XB_SPIN(xb_ld(&bar[XB_XGEN(b.x)]) == gen, bar);
            __builtin_amdgcn_fence(__ATOMIC_ACQUIRE, "agent");
            asm volatile("s_waitcnt vmcnt(0)" ::: "memory");
        }
    }
    __syncthreads();
}
struct U2 { unsigned lo, up; };
__device__ __forceinline__ U2 swap_self(unsigned v) {
    unsigned w = v; asm volatile("" : "+v"(w));
    auto rr = __builtin_amdgcn_permlane32_swap(v, w, false, false); U2 r; r.lo = rr[0]; r.up = rr[1]; return r;
}
__device__ __forceinline__ float swap_add(float v) { const U2 r = swap_self(__builtin_bit_cast(unsigned, v)); return __builtin_bit_cast(float, r.lo) + __builtin_bit_cast(float, r.up); }
__device__ __forceinline__ float swap_max(float v) { const U2 r = swap_self(__builtin_bit_cast(unsigned, v)); return fmaxf(__builtin_bit_cast(float, r.lo), __builtin_bit_cast(float, r.up)); }
template <int O> __device__ __forceinline__ unsigned xor_u(unsigned v) {
    if constexpr (O == 1) return (unsigned)__builtin_amdgcn_update_dpp(0, (int)v, 0xB1, 0xF, 0xF, true);
    else if constexpr (O == 2) return (unsigned)__builtin_amdgcn_update_dpp(0, (int)v, 0x4E, 0xF, 0xF, true);
    else return (unsigned)__builtin_amdgcn_ds_swizzle((int)v, (O << 10) | 0x1F);
}
template <int O> __device__ __forceinline__ float xor_f(float v) { return __builtin_bit_cast(float, xor_u<O>(__builtin_bit_cast(unsigned, v))); }
__device__ __forceinline__ float half_sum32(float v) {
    v += xor_f<1>(v); v += xor_f<2>(v); v += xor_f<4>(v); v += xor_f<8>(v); v += xor_f<16>(v); return v;
}
__device__ __forceinline__ float wave_sum(float v) {
    return swap_add(half_sum32(v));
}
__device__ __forceinline__ float wave_max(float v) {
    v = fmaxf(v, xor_f<1>(v)); v = fmaxf(v, xor_f<2>(v)); v = fmaxf(v, xor_f<4>(v)); v = fmaxf(v, xor_f<8>(v)); v = fmaxf(v, xor_f<16>(v));
    return swap_max(v);
}
__device__ __forceinline__ int wave_sum_i(int v) {
    v += (int)xor_u<1>((unsigned)v); v += (int)xor_u<2>((unsigned)v); v += (int)xor_u<4>((unsigned)v); v += (int)xor_u<8>((unsigned)v); v += (int)xor_u<16>((unsigned)v);
    const U2 r = swap_self((unsigned)v); return (int)(r.lo + r.up);
}
__device__ __forceinline__ float dot4(f32x4 a, f32x4 b) { return (a.x * b.x + a.y * b.y) + (a.z * b.z + a.w * b.w); }

struct Ctx { int tid, lane, wave, G, vcu, gw, NGW; LAS unsigned char* lds; };
__device__ __forceinline__ Ctx fresh(const Ctx& X) {
    Ctx Y = X; int l; asm volatile("v_mbcnt_lo_u32_b32 %0, -1, 0\n\tv_mbcnt_hi_u32_b32 %0, -1, %0" : "=v"(l));
    asm volatile("" : "+s"(Y.wave), "+s"(Y.vcu), "+s"(Y.G));
    Y.lane = l; Y.tid = Y.wave * 64 + l; Y.gw = Y.vcu * NWAVES + Y.wave; Y.NGW = Y.G * NWAVES; return Y;
}

enum { TR_ID = 0, TR_GLU = 1, TR_QKV = 2, TR_DSA = 3 };
__device__ __forceinline__ int tr_src(int r, int mode, int Nsrc) {
    if (mode == TR_ID) return r < Nsrc ? r : -1;
    if (mode == TR_GLU) return ((r >> 7) & 1) * 2048 + (r >> 8) * 128 + (r & 127);
    const int q = r & 127, wc = q >> 5, n = (q >> 4) & 1, f4 = q & 15;
    if (r < 4096 && mode == TR_DSA) return (r & ~127) + 16 * wc + f4 + 64 * n;
    if (r < 6144) return (r & ~127) + 32 * wc + 2 * (f4 & 12) + 4 * n + (f4 & 3);
    if (mode == TR_QKV) return -1;
    if (r < 7168) return (r & ~127) + 64 * (wc >> 1) + 16 * (wc & 1) + f4 + 32 * n;
    if (r < 7168 + 128) { if (wc < 2) return 7168 + 16 * wc + f4 + 32 * n; if (wc == 2 && n == 0) return 7232 + f4; }
    return -1;
}
__device__ __forceinline__ void tr_item(const float* W, int K, int Nsrc, bf16* WT, int mode, int item, int nblk, int lane, LAS unsigned char* stg) {
    const int kb = item / nblk, nb = item - kb * nblk, k0 = 64 * kb, r0 = 128 * nb + 2 * lane, sc4 = tr_src(r0 & ~3, mode, Nsrc), sc = sc4 < 0 ? -1 : sc4 + (r0 & 3);
    f32x2v v[64];
    if (sc >= 0) { const float* src = W + (size_t)k0 * Nsrc + sc;
#pragma unroll
        for (int i = 0; i < 64; ++i) v[i] = *(const f32x2v*)(src + (size_t)i * Nsrc); }
    else {
#pragma unroll
        for (int i = 0; i < 64; ++i) v[i] = (f32x2v){0.f, 0.f}; }
#pragma unroll
    for (int j = 0; j < 2; ++j) {
#pragma unroll
        for (int q = 0; q < 8; ++q) { v4u o; o.x = pg8::cvt_pk_bf16(v[8 * q][j], v[8 * q + 1][j]); o.y = pg8::cvt_pk_bf16(v[8 * q + 2][j], v[8 * q + 3][j]); o.z = pg8::cvt_pk_bf16(v[8 * q + 4][j], v[8 * q + 5][j]); o.w = pg8::cvt_pk_bf16(v[8 * q + 6][j], v[8 * q + 7][j]);
            const int slot = ((((q ^ (lane & 7)) << 1) | j) ^ ((lane >> 3) & 1));
            *(LAS v4u*)(stg + lane * 256 + slot * 16) = o; } }
    LDS_WAIT();
    bf16* dst = WT + (size_t)(128 * nb + (lane >> 3)) * K + k0 + 8 * (lane & 7);
#pragma unroll
    for (int s2 = 0; s2 < 16; ++s2) { const int n = 8 * s2 + (lane >> 3), pp = n >> 1, q = lane & 7;
        const int slot = ((((q ^ (pp & 7)) << 1) | (n & 1)) ^ ((pp >> 3) & 1));
        const v4u o = *(LAS v4u*)(stg + pp * 256 + slot * 16);
        *(v4u*)(dst + (size_t)(8 * s2) * K) = o; }
    LDS_WAIT();
}
__device__ __forceinline__ void tr_matrix(const Ctx& X, const float* W, int K, int Nsrc, int Ndst, bf16* WT, int mode, int& rot, int gw, int ngw) {
    const int nblk = Ndst / 128, nitems = (K / 64) * nblk;
    int first = gw - rot; if (first < 0) first += ngw;
    for (int it = first; it < nitems; it += ngw) tr_item(W, K, Nsrc, WT, mode, it, nblk, X.lane, X.lds + RING_OFF + X.wave * 16384);
    rot = (rot + nitems) % ngw;
}
__device__ __forceinline__ void ph_rope_tables(const Ctx& X, const int* positions, float* CS, float* CS2) {
    for (int idx = X.gw * 64 + X.lane; idx < M * 96; idx += X.NGW * 64) {
        const int m = idx / 96, i = idx - m * 96; const float pos = (float)positions[m];
        if (i < 64) { const float a = pos * exp2f(-(float)i * (13.287712379549449f / 64.0f)); CS[(size_t)m * 128 + i] = cosf(a); CS[(size_t)m * 128 + 64 + i] = sinf(a); }
        else { const int i2 = i - 64; const float a = pos * exp2f(-(float)i2 * (13.287712379549449f / 32.0f)); CS2[(size_t)m * 64 + i2] = cosf(a); CS2[(size_t)m * 64 + 32 + i2] = sinf(a); }
    }
}
__device__ __forceinline__ void ph_mod(const Ctx& X, const float* cin, const float* ada_w, const float* ada_b, float* MOD) {
    LAS float* condl = (LAS float*)(X.lds + RING_OFF);
    LAS float* red = (LAS float*)(X.lds + RING_OFF + 32768);
    for (int i = X.tid; i < NB * D; i += 512) { const float c = cin[i]; condl[i] = c / (1.0f + __expf(-c)); }
    __syncthreads();
    for (int it = (int)((blockIdx.x + X.G - 64 % X.G) % X.G); it < NL * 48; it += X.G) {
        const int l = it / 48, n0 = (it % 48) * 256;
        const float* W = ada_w + (size_t)l * D * (6 * D) + n0 + 4 * X.lane;
        f32x4 a0 = {0.f, 0.f, 0.f, 0.f}, a1 = a0, a2 = a0, a3 = a0;
#pragma unroll 8
        for (int kk = 0; kk < 256; ++kk) { const int k = X.wave * 256 + kk; const f32x4 w = *(const f32x4*)(W + (size_t)k * (6 * D));
            a0 += condl[k] * w; a1 += condl[2048 + k] * w; a2 += condl[4096 + k] * w; a3 += condl[6144 + k] * w; }
        *(LAS f32x4*)(red + (X.wave * 4 + 0) * 256 + 4 * X.lane) = a0; *(LAS f32x4*)(red + (X.wave * 4 + 1) * 256 + 4 * X.lane) = a1;
        *(LAS f32x4*)(red + (X.wave * 4 + 2) * 256 + 4 * X.lane) = a2; *(LAS f32x4*)(red + (X.wave * 4 + 3) * 256 + 4 * X.lane) = a3;
        __syncthreads();
        for (int o = X.tid; o < 1024; o += 512) { const int b = o >> 8, c = o & 255; float s = 0.f;
#pragma unroll
            for (int w = 0; w < 8; ++w) s += red[(w * 4 + b) * 256 + c];
            MOD[(size_t)(l * NB + b) * (6 * D) + n0 + c] = s + ada_b[(size_t)l * (6 * D) + n0 + c]; }
        __syncthreads();
    }
}
__device__ __forceinline__ void ph_ln_mod(const Ctx& X, const float* x, const float* lng, const float* modl, int sh_off, int sc_off, bf16* H) {
    const int lane = X.lane;
    for (int b = 0; b < NB; ++b) {
        if (X.gw >= S) break;
        const float* mb = modl + (size_t)b * (6 * D);
        f32x4 ga[8], sh[8];
#pragma unroll
        for (int j = 0; j < 8; ++j) { const int col = 4 * lane + 256 * j; ga[j] = *(const f32x4*)(lng + col) * (1.0f + *(const f32x4*)(mb + sc_off + col)); sh[j] = *(const f32x4*)(mb + sh_off + col); }
        f32x4 vn[8];
        { const f32x4* xr = (const f32x4*)(x + ((size_t)b * S + X.gw) * D) + lane;
#pragma unroll
          for (int j = 0; j < 8; ++j) vn[j] = xr[64 * j]; }
        for (int t = X.gw; t < S; t += X.NGW) {
            f32x4 v[8];
#pragma unroll
            for (int j = 0; j < 8; ++j) v[j] = vn[j];
            if (t + X.NGW < S) { const f32x4* xr = (const f32x4*)(x + ((size_t)b * S + t + X.NGW) * D) + lane;
#pragma unroll
                for (int j = 0; j < 8; ++j) vn[j] = xr[64 * j]; }
            float ss = 0.f;
#pragma unroll
            for (int j = 0; j < 8; ++j) ss += dot4(v[j], v[j]);
            ss = wave_sum(ss);
            const float r = 1.0f / sqrtf(ss * (1.0f / D) + EPS);
            bf16* hrow = H + ((size_t)b * S + t) * D + 4 * lane;
#pragma unroll
            for (int j = 0; j < 8; ++j) { const f32x4 y = v[j] * r * ga[j] + sh[j];
                v2u o; o.x = pk2(y.x, y.y); o.y = pk2(y.z, y.w);
                *(v2u*)(hrow + 256 * j) = o; }
        }
    }
}
typedef _Float16 h16x8 __attribute__((ext_vector_type(8)));
__device__ __forceinline__ void ph_ln_mod_h(const Ctx& X, const _Float16* x, const float* lng, const float* modl, int sh_off, int sc_off, bf16* H) {
    const int lane = X.lane;
    for (int b = 0; b < NB; ++b) {
        if (X.gw >= S) break;
        const float* mb = modl + (size_t)b * (6 * D);
        f32x4 ga[8], sh[8];
#pragma unroll
        for (int j = 0; j < 8; ++j) { const int col = 8 * lane + 512 * (j >> 1) + 4 * (j & 1); ga[j] = *(const f32x4*)(lng + col) * (1.0f + *(const f32x4*)(mb + sc_off + col)); sh[j] = *(const f32x4*)(mb + sh_off + col); }
        h16x8 vn[4];
        { const h16x8* xr = (const h16x8*)(x + ((size_t)b * S + X.gw) * D) + lane;
#pragma unroll
          for (int j = 0; j < 4; ++j) vn[j] = xr[64 * j]; }
        for (int t = X.gw; t < S; t += X.NGW) {
            f32x4 v[8];
#pragma unroll
            for (int j = 0; j < 4; ++j) { v[2 * j] = (f32x4){(float)vn[j][0], (float)vn[j][1], (float)vn[j][2], (float)vn[j][3]}; v[2 * j + 1] = (f32x4){(float)vn[j][4], (float)vn[j][5], (float)vn[j][6], (float)vn[j][7]}; }
            if (t + X.NGW < S) { const h16x8* xr = (const h16x8*)(x + ((size_t)b * S + t + X.NGW) * D) + lane;
#pragma unroll
                for (int j = 0; j < 4; ++j) vn[j] = xr[64 * j]; }
            float ss = 0.f;
#pragma unroll
            for (int j = 0; j < 8; ++j) ss += dot4(v[j], v[j]);
            ss = wave_sum(ss);
            const float r = 1.0f / sqrtf(ss * (1.0f / D) + EPS);
            bf16* hrow = H + ((size_t)b * S + t) * D + 8 * lane;
#pragma unroll
            for (int j = 0; j < 4; ++j) { const f32x4 y0 = v[2 * j] * r * ga[2 * j] + sh[2 * j], y1 = v[2 * j + 1] * r * ga[2 * j + 1] + sh[2 * j + 1];
                v4u o; o.x = pk2(y0.x, y0.y); o.y = pk2(y0.z, y0.w); o.z = pk2(y1.x, y1.y); o.w = pk2(y1.z, y1.w);
                *(v4u*)(hrow + 512 * j) = o; }
        }
    }
}
#define SEL_WRLANE(w, v, LN) asm("s_nop 1\n\tv_writelane_b32 %0, %1, %2" : "+v"(w) : "s"(v), "i"(LN))
template <int NG8>
__device__ __forceinline__ void sel_row(int lane, int t, __amdgpu_buffer_rsrc_t rS, unsigned row_off, unsigned* bw) {
    constexpr int NR = 8 * NG8, J0 = NR - 8;
    unsigned key[NR];
    const unsigned lane4 = (unsigned)lane * 4u;
#pragma unroll
    for (int j = 0; j < J0; ++j) key[j] = __builtin_amdgcn_raw_buffer_load_b32(rS, lane4, row_off + 256u * j, 0);
#pragma unroll
    for (int j = J0; j < NR; ++j) { const int d4 = 4 * (t - 64 * j); int v4 = (int)lane4 < d4 ? (int)lane4 : d4; v4 = v4 > 0 ? v4 : 0;
        key[j] = __builtin_amdgcn_raw_buffer_load_b32(rS, (unsigned)v4, row_off + 256u * j, 0); }
    asm volatile("" ::: "memory");
#pragma unroll
    for (int j = 0; j < NR; ++j) { const unsigned u = key[j]; const unsigned img = u ^ ((unsigned)((int)u >> 31) | 0x80000000u);
        key[j] = (j < J0 || lane <= t - 64 * j) ? img : 0u; }
    unsigned T = 0u; bool exact = false;
#pragma unroll 1
    for (int bit = 31; bit >= 0; --bit) { const unsigned cand = T | (1u << bit); int cnt = 0;
#pragma unroll
        for (int g8 = 0; g8 < NG8; ++g8) { unsigned long long m0, m1, m2, m3, m4, m5, m6, m7;
            asm volatile("v_cmp_ge_u32_e64 %0, %8, %16\n\tv_cmp_ge_u32_e64 %1, %9, %16\n\tv_cmp_ge_u32_e64 %2, %10, %16\n\tv_cmp_ge_u32_e64 %3, %11, %16\n\t"
                         "v_cmp_ge_u32_e64 %4, %12, %16\n\tv_cmp_ge_u32_e64 %5, %13, %16\n\tv_cmp_ge_u32_e64 %6, %14, %16\n\tv_cmp_ge_u32_e64 %7, %15, %16"
                         : "=s"(m0), "=s"(m1), "=s"(m2), "=s"(m3), "=s"(m4), "=s"(m5), "=s"(m6), "=s"(m7)
                         : "v"(key[g8 * 8]), "v"(key[g8 * 8 + 1]), "v"(key[g8 * 8 + 2]), "v"(key[g8 * 8 + 3]), "v"(key[g8 * 8 + 4]), "v"(key[g8 * 8 + 5]), "v"(key[g8 * 8 + 6]), "v"(key[g8 * 8 + 7]), "v"(cand));
            cnt += (__popcll(m0) + __popcll(m1)) + (__popcll(m2) + __popcll(m3)) + (__popcll(m4) + __popcll(m5)) + (__popcll(m6) + __popcll(m7)); }
        if (cnt >= TOPK) T = cand;
        if (cnt == TOPK) { exact = true; break; } }
    unsigned w0 = 0u, w1 = 0u;
    if (exact) {
#pragma unroll
        for (int j = 0; j < NR; ++j) { const unsigned long long ms = __ballot(key[j] >= T);
            { const unsigned mlo = (unsigned)ms, mhi = (unsigned)(ms >> 32);
            if (j < 32) { SEL_WRLANE(w0, mlo, (2 * j) & 63); SEL_WRLANE(w0, mhi, (2 * j + 1) & 63); }
            else { SEL_WRLANE(w1, mlo, (2 * j) & 63); SEL_WRLANE(w1, mhi, (2 * j + 1) & 63); } } }
    } else {
        int cgt = 0;
#pragma unroll
        for (int j = 0; j < NR; ++j) cgt += __popcll(__ballot(key[j] > T));
        const int need = TOPK - cgt; int run = 0;
#pragma unroll
        for (int j = 0; j < NR; ++j) { const bool gt = key[j] > T, eq = key[j] == T;
            const unsigned long long meq = __ballot(eq);
            const int rank = run + (int)__builtin_amdgcn_mbcnt_hi((unsigned)(meq >> 32), __builtin_amdgcn_mbcnt_lo((unsigned)meq, 0u));
            const bool sel = gt || (eq && rank < need); run += __popcll(meq);
            const unsigned long long ms = __ballot(sel);
            { const unsigned mlo = (unsigned)ms, mhi = (unsigned)(ms >> 32);
            if (j < 32) { SEL_WRLANE(w0, mlo, (2 * j) & 63); SEL_WRLANE(w0, mhi, (2 * j + 1) & 63); }
            else { SEL_WRLANE(w1, mlo, (2 * j) & 63); SEL_WRLANE(w1, mhi, (2 * j + 1) & 63); } } }
    }
    bw[lane] = w0; bw[64 + lane] = w1;
}
__device__ __forceinline__ void ph_idx_scores(const Ctx& X, const bf16* QI, const bf16* KI, const float* WI, float* SC, unsigned* BITS) {
    typedef short bf16x8 __attribute__((ext_vector_type(8)));
    typedef float f32x16 __attribute__((ext_vector_type(16)));
    const int tid = X.tid, lane = X.lane, wid = X.wave, r32 = lane & 31, hi = lane >> 5;
    LAS char* lds = (LAS char*)(X.lds + RING_OFF);
    const __amdgpu_buffer_rsrc_t rK = __builtin_amdgcn_make_buffer_rsrc((void*)KI, (short)0, M * 64 * 2, 0x00020000);
    const __amdgpu_buffer_rsrc_t rQ = __builtin_amdgcn_make_buffer_rsrc((void*)QI, (short)0, M * 1024 * 2, 0x00020000);
    const __amdgpu_buffer_rsrc_t rS = __builtin_amdgcn_make_buffer_rsrc((void*)SC, (short)0, 0x40000000, 0x00020000);
    unsigned st_g[4], st_l[4];
#pragma unroll
    for (int j = 0; j < 4; ++j) { const int p = tid + 512 * j, key = p >> 3, pc = p & 7; st_g[j] = (unsigned)p * 16u; st_l[j] = (unsigned)(key * 128 + ((pc ^ ((key >> 1) & 7)) << 4)); }
    unsigned rd[4];
#pragma unroll
    for (int d0 = 0; d0 < 4; ++d0) rd[d0] = (unsigned)(r32 * 128 + (((2 * d0 + hi) ^ ((r32 >> 1) & 7)) << 4));
    const int qsel = (r32 >> 2) & 1, hsel = (r32 & 3) + 4 * (r32 >> 3);
    for (int slot = X.vcu; slot < 256; slot += X.G) {
        for (int b = 0; b < NB; ++b) {
            const int blk = (b & 1) ? 255 - slot : slot;
            const int t0 = blk * 16, m0 = b * S + t0, tq = t0 + 2 * wid;
            const int nch = (t0 + 15) / 256 + 1;
            bf16x8 afr[4];
#pragma unroll
            for (int d0 = 0; d0 < 4; ++d0) afr[d0] = __builtin_bit_cast(bf16x8, __builtin_amdgcn_raw_buffer_load_b128(rQ, (unsigned)((2 * wid + qsel) * 1024 + hsel * 64 + d0 * 16 + hi * 8) * 2u, (unsigned)m0 * 2048u, 0));
            float wv[16];
#pragma unroll
            for (int q = 0; q < 4; ++q) { const f32x4 w4 = *(const f32x4*)(WI + (size_t)(m0 + 2 * wid + hi) * 16 + 4 * q);
                wv[4 * q] = w4.x; wv[4 * q + 1] = w4.y; wv[4 * q + 2] = w4.z; wv[4 * q + 3] = w4.w; }
            v4u st[4];
            __syncthreads();
#pragma unroll
            for (int j = 0; j < 4; ++j) st[j] = __builtin_amdgcn_raw_buffer_load_b128(rK, st_g[j], (unsigned)(b * S) * 128u, 0);
#pragma unroll
            for (int j = 0; j < 4; ++j) *(LAS v4u*)(lds + st_l[j]) = st[j];
            __syncthreads();
            for (int c = 0; c < nch; ++c) {
                const int kb = c * 256, buf = c & 1; const bool more = c + 1 < nch;
                if (more) {
#pragma unroll
                    for (int j = 0; j < 4; ++j) st[j] = __builtin_amdgcn_raw_buffer_load_b128(rK, st_g[j], (unsigned)(b * S + kb + 256) * 128u, 0); }
                const LAS char* cb = lds + buf * 32768;
                const unsigned srow = (unsigned)(m0 + 2 * wid) * (unsigned)(S * 4) + (unsigned)kb * 4u;
                const int ngrp = ((tq + 1 - kb) >> 5) + 1;
#define IDX_LOADB(GP, B0, B1) _Pragma("unroll") for (int d0 = 0; d0 < 4; ++d0) { B0[d0] = *(const LAS bf16x8*)(cb + (2 * (GP)) * 4096 + rd[d0]); B1[d0] = *(const LAS bf16x8*)(cb + (2 * (GP) + 1) * 4096 + rd[d0]); }
#define IDX_MMA(B0, B1, A0, A1) _Pragma("unroll") for (int d0 = 0; d0 < 4; ++d0) { A0 = __builtin_amdgcn_mfma_f32_32x32x16_bf16(afr[d0], B0[d0], A0, 0, 0, 0); A1 = __builtin_amdgcn_mfma_f32_32x32x16_bf16(afr[d0], B1[d0], A1, 0, 0, 0); }
#define IDX_FIN(ACC, GRP) do { typedef int i32x16 __attribute__((ext_vector_type(16))); \
                    const f32x16 rl_ = __builtin_bit_cast(f32x16, __builtin_elementwise_max(__builtin_bit_cast(i32x16, ACC), (i32x16)(0)));     \
                    float s0_ = 0.f, s1_ = 0.f; _Pragma("unroll") for (int r = 0; r < 16; r += 2) { s0_ = __builtin_fmaf(wv[r], rl_[r], s0_); s1_ = __builtin_fmaf(wv[r + 1], rl_[r + 1], s1_); } \
                    __builtin_amdgcn_raw_buffer_store_b32(__builtin_bit_cast(unsigned, s0_ + s1_), rS, (unsigned)(hi * (S * 4) + ((GRP) * 32 + r32) * 4), srow, 0); } while (0)
                if (ngrp >= 8) {
                    bf16x8 bA[4], bB[4]; f32x16 pa0 = {}, pa1 = {};
                    IDX_LOADB(0, bA, bB); IDX_MMA(bA, bB, pa0, pa1);
#pragma unroll
                    for (int gp = 0; gp < 4; ++gp) {
                        f32x16 na0 = {}, na1 = {};
                        if (gp < 3) { IDX_LOADB(gp + 1, bA, bB); IDX_MMA(bA, bB, na0, na1); }
                        IDX_FIN(pa0, 2 * gp); IDX_FIN(pa1, 2 * gp + 1);
                        pa0 = na0; pa1 = na1;
                    }
                } else {
#pragma unroll
                    for (int gp = 0; gp < 4; ++gp) {
                        if (2 * gp < ngrp) {
                            bf16x8 bA[4], bB[4]; f32x16 pa0 = {}, pa1 = {};
                            IDX_LOADB(gp, bA, bB); IDX_MMA(bA, bB, pa0, pa1);
                            IDX_FIN(pa0, 2 * gp); IDX_FIN(pa1, 2 * gp + 1);
                        }
                    }
                }
#undef IDX_LOADB
#undef IDX_MMA
#undef IDX_FIN
                if (more) {
#pragma unroll
                    for (int j = 0; j < 4; ++j) *(LAS v4u*)(lds + (buf ^ 1) * 32768 + st_l[j]) = st[j]; }
                __syncthreads();
            }
            asm volatile("s_waitcnt vmcnt(0)" ::: "memory");
#pragma unroll 1
            for (int r = 0; r < 2; ++r) {
                const int t = tq + r, m = m0 + 2 * wid + r;
                unsigned* bw = BITS + (size_t)m * 128;
                if (t < TOPK) {
#pragma unroll
                    for (int q = 0; q < 2; ++q) { const int w = lane + 64 * q, lo = 32 * w; bw[w] = (t >= lo + 31) ? 0xffffffffu : (t < lo ? 0u : ((2u << (t - lo)) - 1u)); }
                    continue;
                }
                const unsigned row_off = (unsigned)m * (unsigned)(S * 4);
                switch (t >> 9) {
                    case 0: sel_row<1>(lane, t, rS, row_off, bw); break;
                    case 1: sel_row<2>(lane, t, rS, row_off, bw); break;
                    case 2: sel_row<3>(lane, t, rS, row_off, bw); break;
                    case 3: sel_row<4>(lane, t, rS, row_off, bw); break;
                    case 4: sel_row<5>(lane, t, rS, row_off, bw); break;
                    case 5: sel_row<6>(lane, t, rS, row_off, bw); break;
                    case 6: sel_row<7>(lane, t, rS, row_off, bw); break;
                    default: sel_row<8>(lane, t, rS, row_off, bw); break;
                }
            }
        }
    }
}
__device__ __forceinline__ void ph_s5_pre(const Ctx& X, const float* lre, const float* lim, const float* logdt, const float* bre, const float* bim, const float* cre, const float* cim,
                                          float* S5C, bf16* B1, bf16* B3) {
    LAS float* APr = (LAS float*)(X.lds + RING_OFF);
    LAS float* APi = APr + 17 * 64;
    LAS float* BBr = APi + 17 * 64;
    LAS float* BBi = BBr + 1024;
    LAS float* CR = BBi + 1024;
    LAS float* CI = CR + 1024;
    LAS float* KT = CI + 1024;
    float* AT16R = S5C; float* AT16I = S5C + G5 * P5;
    for (int w2 = blockIdx.x; 2 * w2 < G5; w2 += X.G) for (int e2 = 0; e2 < 2; ++e2) {
        const int g = 2 * w2 + e2;
        __syncthreads();
        if (X.tid < 64) { const int p = X.tid, gp = g * 64 + p;
            const float dt = expf(logdt[g]), lr = lre[gp], li = lim[gp];
            const float mag = expf(lr * dt), ang = li * dt, ar = mag * cosf(ang), ai = mag * sinf(ang);
            const float den = lr * lr + li * li;
            const float fr = ((ar - 1.0f) * lr + ai * li) / den, fi = (ai * lr - (ar - 1.0f) * li) / den;
            float pr = 1.0f, pi = 0.0f;
            for (int tau = 0; tau <= 16; ++tau) { APr[tau * 64 + p] = pr; APi[tau * 64 + p] = pi; const float nr = pr * ar - pi * ai, ni = pr * ai + pi * ar; pr = nr; pi = ni; }
            AT16R[gp] = APr[16 * 64 + p]; AT16I[gp] = APi[16 * 64 + p];
            for (int c = 0; c < C5; ++c) { const float br = bre[(size_t)gp * C5 + c], bi = bim[(size_t)gp * C5 + c]; BBr[p * 16 + c] = fr * br - fi * bi; BBi[p * 16 + c] = fr * bi + fi * br; } }
        for (int i = X.tid; i < 1024; i += 512) { CR[i] = cre[(size_t)g * 1024 + i]; CI[i] = cim[(size_t)g * 1024 + i]; }
        __syncthreads();
        for (int o = X.tid; o < 4096; o += 512) { const int tau = o >> 8, c = (o >> 4) & 15, cp = o & 15; float sacc = 0.f;
            for (int p = 0; p < 64; ++p) { const float ar_ = APr[tau * 64 + p], ai_ = APi[tau * 64 + p], br_ = BBr[p * 16 + cp], bi_ = BBi[p * 16 + cp];
                sacc += CR[c * 64 + p] * (ar_ * br_ - ai_ * bi_) - CI[c * 64 + p] * (ar_ * bi_ + ai_ * br_); }
            KT[o] = sacc; }
        __syncthreads();
        bf16* b3 = B3 + (size_t)g * 256 * 384;
        for (int idx = X.tid; idx < 256 * 192; idx += 512) { const int n = idx / 192, kp = idx - n * 192, t = n >> 4, c = n & 15; float v[2];
#pragma unroll
            for (int e = 0; e < 2; ++e) { const int k = 2 * kp + e;
                if (k < 256) { const int sx = k >> 4, cp = k & 15; v[e] = (sx <= t) ? KT[((t - sx) << 8) + (c << 4) + cp] : 0.f; }
                else if (k < 320) { const int p = k - 256; v[e] = CR[c * 64 + p] * APr[(t + 1) * 64 + p] - CI[c * 64 + p] * APi[(t + 1) * 64 + p]; }
                else { const int p = k - 320; v[e] = -(CR[c * 64 + p] * APi[(t + 1) * 64 + p] + CI[c * 64 + p] * APr[(t + 1) * 64 + p]); } }
            *(unsigned*)(b3 + (size_t)n * 384 + 2 * kp) = pk2(v[0], v[1]); }
        bf16* b1 = B1 + (size_t)g * 256 * 256;
        for (int idx = X.tid; idx < 256 * 128; idx += 512) { const int n = idx >> 7, kp = idx & 127; float v[2] = {0.f, 0.f};
            if (n < 128) { const int ri = n >> 6, p = n & 63;
#pragma unroll
                for (int e = 0; e < 2; ++e) { const int k = 2 * kp + e, sx = k >> 4, cp = k & 15; const float ar_ = APr[(15 - sx) * 64 + p], ai_ = APi[(15 - sx) * 64 + p], br_ = BBr[p * 16 + cp], bi_ = BBi[p * 16 + cp];
                    v[e] = ri ? (ar_ * bi_ + ai_ * br_) : (ar_ * br_ - ai_ * bi_); } }
            *(unsigned*)(b1 + (size_t)n * 256 + 2 * kp) = pk2(v[0], v[1]); }
    }
    __syncthreads();
}
__device__ __forceinline__ void ph_s5_carry(const Ctx& X, const float* S5C, const float* E, bf16* AG) {
    const float* AT16R = S5C; const float* AT16I = S5C + G5 * P5;
    const int lane = X.lane;
    for (int it = X.gw; it < G5 * NB; it += X.NGW) {
        const int g = it >> 2, b = it & 3; const float ar = AT16R[g * 64 + lane], ai = AT16I[g * 64 + lane];
        const float* er = E + (size_t)(g * 1024 + b * 256) * 128 + lane; bf16* hrow = AG + (size_t)(g * 1024 + b * 256) * 384 + 256 + lane;
        float hr = 0.f, hi = 0.f;
        for (int k0 = 0; k0 < 256; k0 += 16) { float e0[16], e1[16];
#pragma unroll
            for (int q = 0; q < 16; ++q) { e0[q] = er[(size_t)(k0 + q) * 128]; e1[q] = er[(size_t)(k0 + q) * 128 + 64]; }
#pragma unroll
            for (int q = 0; q < 16; ++q) { hrow[(size_t)(k0 + q) * 384] = (bf16)f2bf(hr); hrow[(size_t)(k0 + q) * 384 + 64] = (bf16)f2bf(hi);
                const float nr = ar * hr - ai * hi + e0[q], ni = ar * hi + ai * hr + e1[q]; hr = nr; hi = ni; } }
    }
}
namespace att {
typedef short bf16x8 __attribute__((ext_vector_type(8)));
typedef short s16x4 __attribute__((ext_vector_type(4)));
typedef float f32x16 __attribute__((ext_vector_type(16)));
constexpr int KVBLK = 64, SHM_K = KVBLK * HD * 2, SHM_V = SHM_K;
constexpr int OFF_V = 0, OFF_K = 2 * SHM_V, OFF_WS = 2 * SHM_V + 2 * SHM_K, OFF_FLAG = OFF_WS + NWAVES * 256;
#define KSWZ(row, colB) ((row) * 256 + ((colB) ^ (((row) & 7) << 4)))
__device__ __forceinline__ int v_st(int k, int c) { const int kk = (k & ~0xC) | ((k & 4) << 1) | ((k & 8) >> 1); return ((kk >> 3) * 4 + (c >> 5)) * 512 + ((kk & 7) * 32 + (c & 31)) * 2; }
__device__ __forceinline__ int v_rd_base(int lane) { return ((lane & 3) << 3) | (((lane >> 2) & 3) << 6) | (((lane >> 4) & 1) << 5) | (((lane >> 5) & 1) << 8); }
constexpr int v_rd_off(int d0, int ks, int half) { return d0 * 512 + ks * 4096 + half * 2048; }
__device__ __forceinline__ int crow(int r, int hi) { return (r & 3) + 8 * (r >> 2) + 4 * hi; }
__device__ __forceinline__ unsigned cvtpk(float lo, float hi) { unsigned r; asm volatile("v_cvt_pk_bf16_f32 %0, %1, %2" : "=v"(r) : "v"(lo), "v"(hi)); return r; }
#define ATT_PK4(P, B_, OUT) do { unsigned a0 = cvtpk(P[B_+0], P[B_+1]), a1 = cvtpk(P[B_+2], P[B_+3]);                          \
        unsigned b0 = cvtpk(P[B_+4], P[B_+5]), b1 = cvtpk(P[B_+6], P[B_+7]);                                             \
        auto r0 = __builtin_amdgcn_permlane32_swap(a0, b0, false, false); auto r1 = __builtin_amdgcn_permlane32_swap(a1, b1, false, false); \
        v4u w = {r0[0], r1[0], r0[1], r1[1]}; OUT = *reinterpret_cast<bf16x8*>(&w); } while (0)

__device__ __forceinline__ void qkt(f32x16& p0, f32x16& p1, const LAS char* Kt, int r32, int hi, const bf16x8* qr) {
    p0 = f32x16{}; p1 = f32x16{};
    const LAS char* kb[4];
#pragma unroll
    for (int dd = 0; dd < 4; ++dd) kb[dd] = Kt + KSWZ(r32, (dd * 16 + hi * 8) * 2);
#pragma unroll
    for (int d0 = 0; d0 < 8; ++d0) { const LAS char* a = kb[d0 & 3] + (d0 >> 2) * 128;
        const bf16x8 b0 = *reinterpret_cast<const LAS bf16x8*>(a);
        const bf16x8 b1 = *reinterpret_cast<const LAS bf16x8*>(a + 32 * 256);
        p0 = __builtin_amdgcn_mfma_f32_32x32x16_bf16(b0, qr[d0], p0, 0, 0, 0);
        p1 = __builtin_amdgcn_mfma_f32_32x32x16_bf16(b1, qr[d0], p1, 0, 0, 0); }
}
__device__ __forceinline__ void pv_tile(f32x16* o, int vb0, bf16x8 pa0, bf16x8 pa1, bf16x8 pa2, bf16x8 pa3) {
#define ATT_TRRD(dst, off) asm volatile("ds_read_b64_tr_b16 %0, %1 offset:%2" : "=&v"(dst) : "v"(vb0), "i"(off) : "memory")
#define ATT_PV_D0(d0) do { s16x4 l0, l1, l2, l3, h0, h1, h2, h3; constexpr int b_ = v_rd_off(d0, 0, 0); \
        ATT_TRRD(l0, b_); ATT_TRRD(h0, b_ + 2048); ATT_TRRD(l1, b_ + 4096); ATT_TRRD(h1, b_ + 6144); ATT_TRRD(l2, b_ + 8192); ATT_TRRD(h2, b_ + 10240); ATT_TRRD(l3, b_ + 12288); ATT_TRRD(h3, b_ + 14336); \
        asm volatile("s_waitcnt lgkmcnt(0)" ::: "memory"); __builtin_amdgcn_sched_barrier(0);   \
        o[d0] = __builtin_amdgcn_mfma_f32_32x32x16_bf16((bf16x8){l0[0], l0[1], l0[2], l0[3], h0[0], h0[1], h0[2], h0[3]}, pa0, o[d0], 0, 0, 0);   \
        o[d0] = __builtin_amdgcn_mfma_f32_32x32x16_bf16((bf16x8){l1[0], l1[1], l1[2], l1[3], h1[0], h1[1], h1[2], h1[3]}, pa1, o[d0], 0, 0, 0);   \
        o[d0] = __builtin_amdgcn_mfma_f32_32x32x16_bf16((bf16x8){l2[0], l2[1], l2[2], l2[3], h2[0], h2[1], h2[2], h2[3]}, pa2, o[d0], 0, 0, 0);   \
        o[d0] = __builtin_amdgcn_mfma_f32_32x32x16_bf16((bf16x8){l3[0], l3[1], l3[2], l3[3], h3[0], h3[1], h3[2], h3[3]}, pa3, o[d0], 0, 0, 0); } while (0)
    ATT_PV_D0(0); ATT_PV_D0(1); ATT_PV_D0(2); ATT_PV_D0(3);
#undef ATT_PV_D0
#undef ATT_TRRD
}
__device__ __forceinline__ void store_o_rows(const f32x16* o, float scale, __amdgpu_buffer_rsrc_t rO, unsigned rowoff, unsigned soff) {
#pragma unroll
    for (int d0 = 0; d0 < 4; ++d0) {
        unsigned gx[4], gy[4];
#pragma unroll
        for (int g = 0; g < 4; ++g) { gx[g] = cvtpk(o[d0][4 * g] * scale, o[d0][4 * g + 1] * scale); gy[g] = cvtpk(o[d0][4 * g + 2] * scale, o[d0][4 * g + 3] * scale); }
#pragma unroll
        for (int k = 0; k < 4; k += 2) {
            auto rx = __builtin_amdgcn_permlane32_swap(gx[k], gx[k + 1], false, false); auto ry = __builtin_amdgcn_permlane32_swap(gy[k], gy[k + 1], false, false);
            const v4u w = {rx[0], ry[0], rx[1], ry[1]};
            __builtin_amdgcn_raw_buffer_store_b128(w, rO, rowoff + (unsigned)(d0 * 64 + k * 16), soff, 0); }
    }
}
template <bool NEEDMASK>
__device__ __forceinline__ void sb_tile(f32x16& p0, f32x16& p1, float& R, int dq, int hi) {
    float G[8];
#pragma unroll
    for (int half = 0; half < 2; ++half) {
        f32x16& p = half ? p1 : p0;
#pragma unroll
        for (int i = 0; i < 4; ++i) {
            float be[4], rc[4];
#pragma unroll
            for (int j = 0; j < 4; ++j) { const int c = j + 8 * i + 32 * half;
                const float e = __builtin_amdgcn_exp2f(p[4 * i + j]); rc[j] = __builtin_amdgcn_rcpf(1.0f + e); be[j] = 1.0f - rc[j];
                if (NEEDMASK) { const bool ok = c < dq; rc[j] = ok ? rc[j] : 1.0f; be[j] = ok ? be[j] : 0.0f; } }
            const float s2 = rc[3], s1 = s2 * rc[2], s0 = s1 * rc[1];
            G[4 * half + i] = s0 * rc[0];
            p[4 * i + 3] = be[3]; p[4 * i + 2] = be[2] * s2; p[4 * i + 1] = be[1] * s1; p[4 * i + 0] = be[0] * s0;
        }
    }
    float T[8], Pn[8];
#pragma unroll
    for (int g = 0; g < 8; ++g) { const U2 rr = swap_self(__builtin_bit_cast(unsigned, G[g]));
        const float lo = __builtin_bit_cast(float, rr.lo), up = __builtin_bit_cast(float, rr.up);
        T[g] = lo * up; Pn[g] = hi ? 1.0f : up; }
    float ST = 1.0f;
#pragma unroll
    for (int g = 7; g >= 0; --g) { const float A = R * ST * Pn[g]; f32x16& p = (g >> 2) ? p1 : p0; const int i = g & 3;
        p[4 * i + 0] *= A; p[4 * i + 1] *= A; p[4 * i + 2] *= A; p[4 * i + 3] *= A;
        ST *= T[g]; }
    R *= ST;
}

__device__ __forceinline__ bool R_any_alive(float R) { return __any(R != 0.0f) != 0; }
template <int MODE, bool STAGGER>
__device__ __forceinline__ void attn_phase(const Ctx& X, const bf16* QN, const bf16* KN, const bf16* VN, const unsigned* BITS, bf16* O) {
    const int tid = X.tid, wid = X.wave, lane = X.lane, r32 = lane & 31, hi = lane >> 5;
    LAS char* lds = (LAS char*)(X.lds + RING_OFF);
    const bool late = STAGGER && wid >= 4;
    LAS char* V_lds = lds; LAS char* K_lds = lds + 3 * SHM_V;
    volatile LAS unsigned* flags = (volatile LAS unsigned*)(lds + 3 * SHM_V + 2 * SHM_K);
    const int sr = tid >> 4, sc = (tid & 15) * 8, vst0 = v_st(sr, sc), vst1 = v_st(32 + sr, sc), kws = KSWZ(sr, sc * 2);
    const int vbase = (int)(uintptr_t)V_lds + v_rd_base(lane);
    const unsigned voff0 = (unsigned)(sr * D + sc) * 2u, voff1 = voff0 + 32u * D * 2u;
    const unsigned qoff = (unsigned)((wid * 32 + r32) * D + hi * 8) * 2u;
    const unsigned boff = (unsigned)(wid * 32 + r32) * 512u;
    const __amdgpu_buffer_rsrc_t rK = __builtin_amdgcn_make_buffer_rsrc((void*)KN, (short)0, M * D * 2, 0x00020000);
    const __amdgpu_buffer_rsrc_t rV = __builtin_amdgcn_make_buffer_rsrc((void*)VN, (short)0, M * D * 2, 0x00020000);
    const __amdgpu_buffer_rsrc_t rQ = __builtin_amdgcn_make_buffer_rsrc((void*)QN, (short)0, M * D * 2, 0x00020000);
    const __amdgpu_buffer_rsrc_t rO = __builtin_amdgcn_make_buffer_rsrc((void*)O, (short)0, M * D * 2, 0x00020000);
    const __amdgpu_buffer_rsrc_t rB = __builtin_amdgcn_make_buffer_rsrc((void*)(MODE == 1 ? (const void*)BITS : (const void*)QN), (short)0, M * 128 * 4, 0x00020000);
    for (int slot = X.vcu; slot < 256; slot += X.G) {
        const int bh = slot >> 2, sub = slot & 3, b = bh >> 4, h = bh & 15;
        const unsigned kvso = (unsigned)((b * S) * D + h * HD) * 2u;
        for (int qi = 0; qi < 4; ++qi) {
            const int qb = (qi == 0) ? sub : (qi == 1) ? 7 - sub : (qi == 2) ? 8 + sub : 15 - sub;
            const int P0 = qb * 256, NT = P0 / KVBLK + 4;
            const int qlo = P0 + wid * 32, qpos = qlo + r32;
            const unsigned qso = (unsigned)((b * S + P0) * D + h * HD) * 2u, bso = (unsigned)(b * S + P0) * 512u;
            bf16x8 qr[8];
#pragma unroll
            for (int d0 = 0; d0 < 8; ++d0) { const v4u q4 = __builtin_amdgcn_raw_buffer_load_b128(rQ, qoff + d0 * 32u, qso, 0); qr[d0] = __builtin_bit_cast(bf16x8, q4); }
            f32x16 o[4] = {};
            float R = 1.0f, m_reg = -1e30f, l_reg = 0.f;
            bf16x8 st_k0, st_k1, st_v0, st_v1;
#define ATT_KB(t) ((MODE == 0) ? (NT - 1 - (t)) * KVBLK : (t) * KVBLK)
#define ATT_LOAD(kb_) do { const unsigned so_ = kvso + (unsigned)(kb_) * (D * 2u); \
                           st_k0 = __builtin_bit_cast(bf16x8, __builtin_amdgcn_raw_buffer_load_b128(rK, voff0, so_, 0)); st_k1 = __builtin_bit_cast(bf16x8, __builtin_amdgcn_raw_buffer_load_b128(rK, voff1, so_, 0)); \
                           st_v0 = __builtin_bit_cast(bf16x8, __builtin_amdgcn_raw_buffer_load_b128(rV, voff0, so_, 0)); st_v1 = __builtin_bit_cast(bf16x8, __builtin_amdgcn_raw_buffer_load_b128(rV, voff1, so_, 0)); } while (0)
#define ATT_WRITE(kbf, vbf) do { *reinterpret_cast<LAS bf16x8*>(K_lds + (kbf) * SHM_K + kws) = st_k0; *reinterpret_cast<LAS bf16x8*>(K_lds + (kbf) * SHM_K + kws + 32 * 256) = st_k1; \
                           *reinterpret_cast<LAS bf16x8*>(V_lds + (vbf) * SHM_V + vst0) = st_v0; *reinterpret_cast<LAS bf16x8*>(V_lds + (vbf) * SHM_V + vst1) = st_v1; } while (0)
            __syncthreads();
            ATT_LOAD(ATT_KB(0)); ATT_WRITE(0, 0);
            bf16x8 pa0, pa1, pa2, pa3; bool pend = false; int vb = 0, vbp = 0;
            unsigned mw0 = 0u, mw1 = 0u;
            if (MODE == 1) { const v2u bw = __builtin_amdgcn_raw_buffer_load_b64(rB, boff, bso, 0); mw0 = bw.x; mw1 = bw.y; }
            __syncthreads();
            for (int t = 0; t < NT; ++t) {
                const int kb = ATT_KB(t), buf = t & 1;
                const bool more = t + 1 < NT;
                if (more) ATT_LOAD(ATT_KB(t + 1));
                unsigned nw0 = 0u, nw1 = 0u;
                if (MODE == 1 && more) { const v2u bw = __builtin_amdgcn_raw_buffer_load_b64(rB, boff, bso + (unsigned)((kb + KVBLK) >> 5) * 4u, 0); nw0 = bw.x; nw1 = bw.y; }
                if (late && pend) { pv_tile(o, vbase + vbp * SHM_V, pa0, pa1, pa2, pa3); pend = false; }
                const bool act = (MODE == 0) ? (kb < qlo + 31 && R_any_alive(R)) : (kb <= qlo + 31);
                if (act) {
                    f32x16 p0, p1;
                    qkt(p0, p1, K_lds + buf * SHM_K, r32, hi, qr);
                    if (MODE == 0) {
                        if (kb + KVBLK - 1 >= qlo) sb_tile<true>(p0, p1, R, qpos - kb - 4 * hi, hi); else sb_tile<false>(p0, p1, R, 0, hi);
                    } else {
                        const float NEG = -__builtin_inff();
                        const unsigned s0 = mw0 >> (4 * hi), s1 = mw1 >> (4 * hi);
#pragma unroll
                        for (int r = 0; r < 16; ++r) { const unsigned bit = 1u << ((r & 3) + 8 * (r >> 2)); p0[r] = (s0 & bit) ? p0[r] : NEG; p1[r] = (s1 & bit) ? p1[r] : NEG; }
                        float pmax = p0[0];
#pragma unroll
                        for (int r = 1; r < 16; ++r) pmax = fmaxf(pmax, p0[r]);
#pragma unroll
                        for (int r = 0; r < 16; ++r) pmax = fmaxf(pmax, p1[r]);
                        pmax = swap_max(pmax);
                        const float mn = fmaxf(m_reg, pmax), alpha = __builtin_amdgcn_exp2f(m_reg - mn); m_reg = mn;
                        float ps = 0.f;
#pragma unroll
                        for (int r = 0; r < 16; ++r) { p0[r] = __builtin_amdgcn_exp2f(p0[r] - mn); p1[r] = __builtin_amdgcn_exp2f(p1[r] - mn); ps += p0[r] + p1[r]; }
                        ps = swap_add(ps);
                        l_reg = l_reg * alpha + ps;
                        if (__any(alpha < 1.0f)) {
#pragma unroll
                            for (int d_ = 0; d_ < 4; ++d_) o[d_] *= alpha; }
                    }
                    ATT_PK4(p0, 0, pa0); ATT_PK4(p0, 8, pa1); ATT_PK4(p1, 0, pa2); ATT_PK4(p1, 8, pa3);
                    if (!late) pv_tile(o, vbase + vb * SHM_V, pa0, pa1, pa2, pa3); else { pend = true; vbp = vb; }
                }
                const int vbn = (vb == 2) ? 0 : vb + 1;
                if (more) ATT_WRITE(buf ^ 1, vbn);
                mw0 = nw0; mw1 = nw1;
                if (MODE == 0) { if (lane == 0) flags[buf * 8 + wid] = R_any_alive(R) ? 1u : 0u; }
                __syncthreads();
                if (MODE == 0) { unsigned alive = 0u;
#pragma unroll
                    for (int w = 0; w < 8; ++w) alive |= flags[buf * 8 + w];
                    if (alive == 0u) break; }
                vb = vbn;
            }
            if (late && pend) pv_tile(o, vbase + vbp * SHM_V, pa0, pa1, pa2, pa3);
            const unsigned oso = (unsigned)((b * S + qlo) * D + h * HD) * 2u;
            store_o_rows(o, (MODE == 1) ? __builtin_amdgcn_rcpf(l_reg) : 1.0f, rO, (unsigned)(r32 * D) * 2u + (unsigned)hi * 16u, oso);
#undef ATT_KB
#undef ATT_LOAD
#undef ATT_WRITE
        }
    }
}
__device__ __forceinline__ void dsa_mask(f32x16& p0, f32x16& p1, unsigned w0, unsigned w1, int hi) {
    const float NEG = -__builtin_inff(); const unsigned s0 = w0 >> (4 * hi), s1 = w1 >> (4 * hi);
#pragma unroll
    for (int r = 0; r < 16; ++r) { const unsigned bit = 1u << ((r & 3) + 8 * (r >> 2)); p0[r] = (s0 & bit) ? p0[r] : NEG; p1[r] = (s1 & bit) ? p1[r] : NEG; }
}
__device__ __forceinline__ void dsa_partial(f32x16& p0, f32x16& p1, float& m_reg, float& mn, float& alpha) {
    float pmax = p0[0];
#pragma unroll
    for (int r = 1; r < 16; ++r) pmax = fmaxf(pmax, p0[r]);
#pragma unroll
    for (int r = 0; r < 16; ++r) pmax = fmaxf(pmax, p1[r]);
    pmax = swap_max(pmax);
    if (__all(pmax - m_reg <= 8.0f)) { mn = m_reg; alpha = 1.0f; }
    else { mn = fmaxf(m_reg, pmax); alpha = __builtin_amdgcn_exp2f(m_reg - mn); m_reg = mn; }
#pragma unroll
    for (int r = 0; r < 16; ++r) p0[r] = __builtin_amdgcn_exp2f(p0[r] - mn);
}
__device__ __forceinline__ void dsa_finish(f32x16& p0, f32x16& p1, float mn, float alpha, float& l_reg, bf16x8& pa0, bf16x8& pa1, bf16x8& pa2, bf16x8& pa3) {
#pragma unroll
    for (int r = 0; r < 16; ++r) p1[r] = __builtin_amdgcn_exp2f(p1[r] - mn);
    float ps = 0.f;
#pragma unroll
    for (int r = 0; r < 16; ++r) ps += p0[r];
#pragma unroll
    for (int r = 0; r < 16; ++r) ps += p1[r];
    ps = swap_add(ps);
    l_reg = l_reg * alpha + ps;
    ATT_PK4(p0, 0, pa0); ATT_PK4(p0, 8, pa1); ATT_PK4(p1, 0, pa2); ATT_PK4(p1, 8, pa3);
}
__device__ __forceinline__ void attn_dsa_pipelined(const Ctx& X, const bf16* QN, const bf16* KN, const bf16* VN, const unsigned* BITS, bf16* O) {
    const int tid = X.tid, wid = X.wave, lane = X.lane, r32 = lane & 31, hi = lane >> 5;
    LAS char* lds = (LAS char*)(X.lds + RING_OFF);
    LAS char* V_lds = lds + OFF_V; LAS char* K_lds = lds + OFF_K;
    LAS float* wsl = (LAS float*)(lds + OFF_WS) + wid * 64;
    const int sr = tid >> 4, sc = (tid & 15) * 8, vst0 = v_st(sr, sc), vst1 = v_st(32 + sr, sc), kws = KSWZ(sr, sc * 2);
    const int vbase = (int)(uintptr_t)V_lds + v_rd_base(lane);
    const unsigned voff0 = (unsigned)(sr * D + sc) * 2u, voff1 = voff0 + 32u * D * 2u;
    const unsigned qoff = (unsigned)((wid * 32 + r32) * D + hi * 8) * 2u;
    const unsigned boff = (unsigned)(wid * 32 + r32) * 512u;
    const __amdgpu_buffer_rsrc_t rK = __builtin_amdgcn_make_buffer_rsrc((void*)KN, (short)0, M * D * 2, 0x00020000);
    const __amdgpu_buffer_rsrc_t rV = __builtin_amdgcn_make_buffer_rsrc((void*)VN, (short)0, M * D * 2, 0x00020000);
    const __amdgpu_buffer_rsrc_t rQ = __builtin_amdgcn_make_buffer_rsrc((void*)QN, (short)0, M * D * 2, 0x00020000);
    const __amdgpu_buffer_rsrc_t rO = __builtin_amdgcn_make_buffer_rsrc((void*)O, (short)0, M * D * 2, 0x00020000);
    const __amdgpu_buffer_rsrc_t rB = __builtin_amdgcn_make_buffer_rsrc((void*)BITS, (short)0, M * 128 * 4, 0x00020000);
    for (int slot = X.vcu; slot < 256; slot += X.G) {
        const int bh = slot >> 2, sub = slot & 3, b = bh >> 4, h = bh & 15;
        const unsigned kvso = (unsigned)((b * S) * D + h * HD) * 2u;
        for (int qi = 0; qi < 4; ++qi) {
            const int qb = (qi == 0) ? sub : (qi == 1) ? 7 - sub : (qi == 2) ? 8 + sub : 15 - sub;
            const int P0 = qb * 256, NT = P0 / KVBLK + 4;
            const int qlo = P0 + wid * 32;
            const unsigned qso = (unsigned)((b * S + P0) * D + h * HD) * 2u, bso = (unsigned)(b * S + P0) * 512u;
            bf16x8 qr[8];
#pragma unroll
            for (int d0 = 0; d0 < 8; ++d0) { const v4u q4 = __builtin_amdgcn_raw_buffer_load_b128(rQ, qoff + d0 * 32u, qso, 0); qr[d0] = __builtin_bit_cast(bf16x8, q4); }
            f32x16 o[4] = {};
            float m_reg = -1e30f, l_reg = 0.f;
            bf16x8 st_k0, st_k1, st_v0, st_v1; v2u mwn = {0u, 0u};
#define DSA_LOAD(t_) do { const unsigned so_ = kvso + (unsigned)((t_) * KVBLK) * (D * 2u); \
                          st_k0 = __builtin_bit_cast(bf16x8, __builtin_amdgcn_raw_buffer_load_b128(rK, voff0, so_, 0)); st_k1 = __builtin_bit_cast(bf16x8, __builtin_amdgcn_raw_buffer_load_b128(rK, voff1, so_, 0)); \
                          st_v0 = __builtin_bit_cast(bf16x8, __builtin_amdgcn_raw_buffer_load_b128(rV, voff0, so_, 0)); st_v1 = __builtin_bit_cast(bf16x8, __builtin_amdgcn_raw_buffer_load_b128(rV, voff1, so_, 0)); \
                          mwn = __builtin_amdgcn_raw_buffer_load_b64(rB, boff, bso + (unsigned)(t_) * 8u, 0); } while (0)
#define DSA_WRITE(bf) do { *reinterpret_cast<LAS bf16x8*>(K_lds + (bf) * SHM_K + kws) = st_k0; *reinterpret_cast<LAS bf16x8*>(K_lds + (bf) * SHM_K + kws + 32 * 256) = st_k1; \
                           *reinterpret_cast<LAS bf16x8*>(V_lds + (bf) * SHM_V + vst0) = st_v0; *reinterpret_cast<LAS bf16x8*>(V_lds + (bf) * SHM_V + vst1) = st_v1; } while (0)
#define DSA_ACT(t_) ((t_) * KVBLK <= qlo + 31)
#define DSA_RESC(a) do { if (__any((a) < 1.0f)) { _Pragma("unroll") for (int d_ = 0; d_ < 4; ++d_) o[d_] *= (a); } } while (0)
            f32x16 pA0, pA1, pB0, pB1; float mnA = 0.f, mnB = 0.f, alA = 1.f, alB = 1.f; bf16x8 pa0, pa1, pa2, pa3; unsigned mw0, mw1;
            __syncthreads();
            DSA_LOAD(0); DSA_WRITE(0); mw0 = mwn.x; mw1 = mwn.y;
            DSA_LOAD(1);
            __syncthreads();
            qkt(pA0, pA1, K_lds, r32, hi, qr);
            DSA_WRITE(1);
            dsa_mask(pA0, pA1, mw0, mw1, hi); dsa_partial(pA0, pA1, m_reg, mnA, alA);
            mw0 = mwn.x; mw1 = mwn.y;
            __syncthreads();
#define DSA_HALF(PX0, PX1, mnX, alX, PY0, PY1, mnY, alY, t_, KB, VB, SB_) do { \
                const bool actx = DSA_ACT(t_), acty = DSA_ACT((t_) - 1); \
                if (actx) qkt(PX0, PX1, K_lds + (KB) * SHM_K, r32, hi, qr); \
                if (acty) dsa_finish(PY0, PY1, mnY, alY, l_reg, pa0, pa1, pa2, pa3); \
                if ((t_) + 1 < NT) DSA_LOAD((t_) + 1); \
                if (acty) pv_tile(o, vbase + (VB) * SHM_V, pa0, pa1, pa2, pa3); \
                if (actx) { dsa_mask(PX0, PX1, mw0, mw1, hi); dsa_partial(PX0, PX1, m_reg, mnX, alX); } else { alX = 1.0f; } \
                mw0 = mwn.x; mw1 = mwn.y; \
                __syncthreads(); \
                if ((t_) + 1 < NT) DSA_WRITE(SB_); \
                if (actx) DSA_RESC(alX); \
                __syncthreads(); } while (0)
            for (int t = 1; t + 1 < NT; t += 2) {
                DSA_HALF(pB0, pB1, mnB, alB, pA0, pA1, mnA, alA, t, 1, 0, 0);
                DSA_HALF(pA0, pA1, mnA, alA, pB0, pB1, mnB, alB, t + 1, 0, 1, 1);
            }
            { const bool actx = DSA_ACT(NT - 1), acty = DSA_ACT(NT - 2);
              if (actx) qkt(pB0, pB1, K_lds + SHM_K, r32, hi, qr);
              if (acty) { dsa_finish(pA0, pA1, mnA, alA, l_reg, pa0, pa1, pa2, pa3); pv_tile(o, vbase, pa0, pa1, pa2, pa3); }
              if (actx) { dsa_mask(pB0, pB1, mw0, mw1, hi); dsa_partial(pB0, pB1, m_reg, mnB, alB); DSA_RESC(alB);
                          dsa_finish(pB0, pB1, mnB, alB, l_reg, pa0, pa1, pa2, pa3); pv_tile(o, vbase + SHM_V, pa0, pa1, pa2, pa3); } }
            const unsigned oso = (unsigned)((b * S + qlo) * D + h * HD) * 2u;
            store_o_rows(o, __builtin_amdgcn_rcpf(l_reg), rO, (unsigned)(r32 * D) * 2u + (unsigned)hi * 16u, oso);
#undef DSA_LOAD
#undef DSA_WRITE
#undef DSA_ACT
#undef DSA_RESC
#undef DSA_HALF
        }
    }
}
}
struct Args { const void* in[27]; float* out; unsigned char* ws; };
typedef const void* cvp_t;
__device__ __forceinline__ const void* karg(int i) {
    unsigned long long a = (unsigned long long)__builtin_amdgcn_kernarg_segment_ptr(); asm volatile("" : "+s"(a));
    return ((const __attribute__((address_space(4))) cvp_t*)a)[i];
}
enum { I_X = 0, I_C, I_POS, I_LN1G, I_LN2G, I_ADAW, I_ADAB, I_W1, I_W2, I_SBWIN, I_SBQG, I_SBKG, I_SBWOUT, I_S5WIN, I_S5LRE, I_S5LIM, I_S5LOGDT, I_S5BRE, I_S5BIM,
       I_S5CRE, I_S5CIM, I_S5D, I_S5WGLU, I_DSAWIN, I_DSAQG, I_DSAKG, I_DSAWOUT };

__global__ void __launch_bounds__(NWAVES * 64, 2) fwd_kernel(Args args) {
    extern __shared__ __attribute__((aligned(16))) unsigned char lds_raw[];
    Ctx X;
    X.lds = (LAS unsigned char*)lds_raw;
    X.tid = threadIdx.x; X.lane = X.tid & 63; X.wave = __builtin_amdgcn_readfirstlane(X.tid >> 6);
    X.G = gridDim.x; { const int bx = blockIdx.x; X.vcu = (X.G % 8 == 0) ? (bx % 8) * (X.G / 8) + bx / 8 : bx; }
    X.gw = X.vcu * NWAVES + X.wave; X.NGW = X.G * NWAVES;
    unsigned* ctl = (unsigned*)(args.ws + WS_CTL);
    for (int u = X.tid; u < (LDS_BYTES - LDSCTL_OFF) / 4; u += NWAVES * 64) ((LAS unsigned*)(X.lds + LDSCTL_OFF))[u] = 0u;
    __syncthreads();
    volatile LAS unsigned* MISC = (volatile LAS unsigned*)(X.lds + MISC_OFF);
    XcdBarrier bar = xcd_barrier_post(ctl + CW_BAR, MISC + 8);
#define GRID_BAR() do { XcdBarrier bb_ = bar; asm volatile("" : "+s"(bb_.x), "+s"(bb_.bar)); const Ctx xb_ = fresh(X); xcd_barrier(bb_, xb_.tid == 0); } while (0)

#define INF(i) ((const float*)karg(i))
#define WSP(T, off) ((T*)((unsigned char*)karg(28) + (off)))
#define XOUT ((float*)karg(27))
#define MOD WSP(float, WS_MOD)
#define S5C WSP(float, WS_S5C)
#define W1T WSP(bf16, WS_W1T)
#define W2T WSP(bf16, WS_W2T)
#define SBIN WSP(bf16, WS_SBIN)
#define SBOUT WSP(bf16, WS_SBOUT)
#define S5IN WSP(bf16, WS_S5IN)
#define S5GLU WSP(bf16, WS_S5GLU)
#define DSAIN WSP(bf16, WS_DSAIN)
#define DSAOUT WSP(bf16, WS_DSAOUT)
#define H WSP(bf16, WS_H)
#define BIG WSP(float, WS_BIG)
#define QN WSP(bf16, WS_QN)
#define KN WSP(bf16, WS_KN)
#define VN WSP(bf16, WS_VN)
#define OB WSP(bf16, WS_O)
#define QI WSP(bf16, WS_QI)
#define KI WSP(bf16, WS_KI)
#define WI WSP(float, WS_WI)
#define BITS WSP(unsigned, WS_BITS)
#define E5 WSP(float, WS_E)
#define AG WSP(bf16, WS_AG)
#define XH WSP(_Float16, WS_XH)
#define B1S WSP(bf16, WS_B1)
#define B3S WSP(bf16, WS_B3)
    LAS unsigned char* ring = X.lds + RING_OFF;

    _Pragma("unroll 1") for (int rpro_ = 0; rpro_ < REP_PRO; ++rpro_) {
    _Pragma("unroll 1") for (int rep_ = 0; rep_ < REP_MOD; ++rep_) ph_mod(fresh(X), INF(I_C), INF(I_ADAW), INF(I_ADAB), MOD);
    _Pragma("unroll 1") for (int rep_ = 0; rep_ < REP_S5PRE; ++rep_)
    ph_s5_pre(fresh(X), INF(I_S5LRE), INF(I_S5LIM), INF(I_S5LOGDT), INF(I_S5BRE), INF(I_S5BIM), INF(I_S5CRE), INF(I_S5CIM), S5C, B1S, B3S);
    int trot = 0;
    _Pragma("unroll 1") for (int rep_ = 0; rep_ < REP_TR; ++rep_) {
    for (int l = 0; l < NL - 1; ++l) {
        { const Ctx Y = fresh(X); tr_matrix(Y, INF(I_W1) + (size_t)l * D * FF, D, FF, FF, W1T + (size_t)l * FF * D, 0, trot, Y.gw, Y.NGW); }
        { const Ctx Y = fresh(X); tr_matrix(Y, INF(I_W2) + (size_t)l * FF * D, FF, D, D, W2T + (size_t)l * D * FF, 0, trot, Y.gw, Y.NGW); }
    }
    for (int j = 0; j < 2; ++j) {
        { const Ctx Y = fresh(X); tr_matrix(Y, INF(I_SBWIN) + (size_t)j * D * 3 * D, D, 3 * D, 3 * D, SBIN + (size_t)j * 3 * D * D, TR_QKV, trot, Y.gw, Y.NGW); }
        { const Ctx Y = fresh(X); tr_matrix(Y, INF(I_SBWOUT) + (size_t)j * D * D, D, D, D, SBOUT + (size_t)j * D * D, 0, trot, Y.gw, Y.NGW); }
    }
    { const Ctx Y = fresh(X); tr_matrix(Y, INF(I_S5WIN), D, D, D, S5IN, 0, trot, Y.gw, Y.NGW); }
    { const Ctx Y = fresh(X); tr_matrix(Y, INF(I_S5WGLU), D, 2 * D, 2 * D, S5GLU, TR_GLU, trot, Y.gw, Y.NGW); }
    { const Ctx Y = fresh(X); tr_matrix(Y, INF(I_DSAWIN), D, DSA_N, DSA_NP, DSAIN, TR_DSA, trot, Y.gw, Y.NGW); }
    ph_rope_tables(fresh(X), (const int*)karg(I_POS), WSP(float, WS_CS), WSP(float, WS_CS2));
    { const Ctx Y = fresh(X); tr_matrix(Y, INF(I_DSAWOUT), D, D, D, DSAOUT, 0, trot, Y.gw, Y.NGW); }
    }
    GRID_BAR();
    }

#define XCUR ((l == 0) ? INF(I_X) : (const float*)XOUT)
    for (int l = 0; l < NL; ++l) {
        const int kind = l % 3, jm = l / 3;
        _Pragma("unroll 1") for (int rep_ = 0; rep_ < REP_LN; ++rep_) { if (l == 0) ph_ln_mod(fresh(X), INF(I_X), INF(I_LN1G) + (size_t)l * D, (MOD + (size_t)l * NB * 6 * D), 0, D, H); else ph_ln_mod_h(fresh(X), XH, INF(I_LN1G) + (size_t)l * D, (MOD + (size_t)l * NB * 6 * D), 0, D, H); GRID_BAR(); }
        if (kind == 1) {
            pg8::Gemm g{H, S5IN, M, D, D}; pg8::StaticOrder So; So.init(M, D, X.G, (int)blockIdx.x, WGM_S5U);
            pg8::EpiS5U Ep{AG};
            _Pragma("unroll 1") for (int rep_ = 0; rep_ < REP_S5U; ++rep_) {
            pg8::gemm_phase<pg8::EpiS5U, pg8::StaticOrder, true, true>(ring, g, So, Ep, X.wave);
            GRID_BAR(); }
        } else {
            const bf16* Bt = kind == 0 ? SBIN + (size_t)jm * 3 * D * D : DSAIN;
            const int N = kind == 0 ? 3 * D : DSA_NP;
            pg8::Gemm g{H, Bt, M, N, D}; pg8::StaticOrder So; So.init(M, N, X.G, (int)blockIdx.x, WGM_QKV);
            pg8::EpiQkv Ep{QN, KN, VN, QI, KI, WI, kind == 0 ? INF(I_SBQG) + jm * HD : INF(I_DSAQG), kind == 0 ? INF(I_SBKG) + jm * HD : INF(I_DSAKG), WSP(float, WS_CS), WSP(float, WS_CS2), kind == 2 ? 1 : 0, QSCALE, EPS,
                           (PG8_LAS float*)(X.lds + EPI_OFF)};
            _Pragma("unroll 1") for (int rep_ = 0; rep_ < REP_QKV; ++rep_) {
            Ep.skip = (EPI_NULL && rep_ < REP_QKV - 1) ? 1 : 0;
            pg8::gemm_phase<pg8::EpiQkv, pg8::StaticOrder, true, true>(ring, g, So, Ep, X.wave);
            if (l == 2) {
                const int nun = (M / 256) * (DSA_NP / 256), rounds = (nun + X.G - 1) / X.G; int fi = nun - (rounds - 1) * X.G; if (fi >= X.G) fi = 0;
                if ((int)blockIdx.x >= fi) { int drot = 0; const Ctx Y = fresh(X); const int dgw = ((int)blockIdx.x - fi) * NWAVES + Y.wave, dn = (Y.G - fi) * NWAVES;
                    tr_matrix(Y, INF(I_W1) + (size_t)3 * D * FF, D, FF, FF, W1T + (size_t)3 * FF * D, 0, drot, dgw, dn);
                    tr_matrix(Y, INF(I_W2) + (size_t)3 * FF * D, FF, D, D, W2T + (size_t)3 * D * FF, 0, drot, dgw, dn);
                }
            }
            GRID_BAR(); }
        }
        if (kind == 0) {
            _Pragma("unroll 1") for (int rep_ = 0; rep_ < REP_ATT_SB; ++rep_) { att::attn_phase<0, SB_STAG>(fresh(X), QN, KN, VN, nullptr, OB); GRID_BAR(); }
        } else if (kind == 1) {
            { pg8::Gemm g{AG, B1S, G5 * 1024, 256, 256, 384, 256}; pg8::GroupOrder So{X.G, (int)blockIdx.x};
              pg8::EpiS5E Ep{E5};
              _Pragma("unroll 1") for (int rep_ = 0; rep_ < REP_S5A; ++rep_) {
              pg8::gemm_phase<pg8::EpiS5E, pg8::GroupOrder, true, true>(ring, g, So, Ep, X.wave); if (rep_ < REP_S5A - 1) GRID_BAR(); } }
            GRID_BAR();
            _Pragma("unroll 1") for (int rep_ = 0; rep_ < REP_CARRY; ++rep_) { ph_s5_carry(fresh(X), S5C, E5, AG);
            GRID_BAR(); }
            { pg8::Gemm g{AG, B3S, G5 * 1024, 256, 384, 384, 384}; pg8::GroupOrder So{X.G, (int)blockIdx.x};
              pg8::EpiS5Out Ep{__builtin_amdgcn_make_buffer_rsrc((void*)AG, (short)0, G5 * 1024 * 384 * 2, 0x00020000), __builtin_amdgcn_make_buffer_rsrc((void*)OB, (short)0, M * D * 2, 0x00020000), __builtin_amdgcn_make_buffer_rsrc((void*)INF(I_S5D), (short)0, D * 4, 0x00020000)};
              _Pragma("unroll 1") for (int rep_ = 0; rep_ < REP_S5B; ++rep_) {
              pg8::gemm_phase<pg8::EpiS5Out, pg8::GroupOrder, true, true>(ring, g, So, Ep, X.wave); if (rep_ < REP_S5B - 1) GRID_BAR(); } }
            GRID_BAR();
        } else {
            _Pragma("unroll 1") for (int rep_ = 0; rep_ < REP_IDX; ++rep_) { ph_idx_scores(fresh(X), QI, KI, WI, BIG, BITS); GRID_BAR(); }
            _Pragma("unroll 1") for (int rep_ = 0; rep_ < REP_ATT_DSA; ++rep_) {
#if DSA_VARIANT == 0
            att::attn_dsa_pipelined(fresh(X), QN, KN, VN, BITS, OB);
#elif DSA_VARIANT == 1
            att::attn_phase<1, true>(fresh(X), QN, KN, VN, BITS, OB);
#else
            att::attn_phase<1, false>(fresh(X), QN, KN, VN, BITS, OB);
#endif
            GRID_BAR(); }
        }
        if (kind == 1) {
            pg8::Gemm g{OB, S5GLU, M, 2 * D, D, 0, 0}; pg8::StaticOrder So; So.init(M, 2 * D, X.G, (int)blockIdx.x, WGM_GLU);
            _Pragma("unroll 1") for (int rep_ = 0; rep_ < REP_OUT; ++rep_) {
            pg8::EpiGluRes Ep{XH, rep_ == REP_OUT - 1 ? XH : WSP(_Float16, WS_QN), (MOD + (size_t)l * NB * 6 * D) + 2 * D, 6 * D};
            pg8::gemm_phase<pg8::EpiGluRes, pg8::StaticOrder, true, true, true>(ring, g, So, Ep, X.wave); if (rep_ < REP_OUT - 1) GRID_BAR(); }
        } else {
            const bf16* Bt = kind == 0 ? SBOUT + (size_t)jm * D * D : DSAOUT;
            pg8::Gemm g{OB, Bt, M, D, D}; pg8::StaticOrder So; So.init(M, D, X.G, (int)blockIdx.x, WGM_OUT);
            _Pragma("unroll 1") for (int rep_ = 0; rep_ < REP_OUT; ++rep_) {
            pg8::EpiRes Ep{l == 0 ? (const void*)INF(I_X) : (const void*)XH, rep_ == REP_OUT - 1 ? (void*)XH : (void*)WSP(_Float16, WS_QN), (MOD + (size_t)l * NB * 6 * D) + 2 * D, 6 * D, l == 0 ? 1 : 0, 0};
            pg8::gemm_phase<pg8::EpiRes, pg8::StaticOrder, true, true>(ring, g, So, Ep, X.wave); if (rep_ < REP_OUT - 1) GRID_BAR(); }
        }
        GRID_BAR();
        _Pragma("unroll 1") for (int rep_ = 0; rep_ < REP_LN; ++rep_) { ph_ln_mod_h(fresh(X), XH, INF(I_LN2G) + (size_t)l * D, (MOD + (size_t)l * NB * 6 * D), 3 * D, 4 * D, H); GRID_BAR(); }
        _Pragma("unroll 1") for (int rep_ = 0; rep_ < REP_MLP; ++rep_) {
#define XDST(fin) ((fin) ? (l == NL - 1 ? (void*)(XOUT + r0 * D) : (void*)(XH + r0 * D)) : (l == NL - 1 ? (void*)(WSP(float, WS_QN) + r0 * D) : (void*)(WSP(_Float16, WS_QN) + r0 * D)))
#if MLP_VARIANT >= 1
        _Pragma("unroll 1") for (int st = 0; st < 3; ++st) {
            const int first_up = (MLP_VARIANT == 2 && st == 1) ? ((int)blockIdx.x & 1) : 0;
            _Pragma("unroll 1") for (int sub = 0; sub < 2; ++sub) {
            if ((sub ^ first_up) == 0) { if (st > 0) {
                const int hf = st - 1; const size_t r0 = (size_t)hf * (M / 2);
                pg8::Gemm g{(const bf16*)BIG + (size_t)hf * (M / 2) * FF, W2T + (size_t)l * D * FF, M / 2, D, FF}; pg8::StaticOrder So; So.init(M / 2, D, X.G, (int)blockIdx.x, WGM_W2);
                pg8::EpiRes Ep{XH + r0 * D, XDST(rep_ == REP_MLP - 1), (MOD + (size_t)l * NB * 6 * D) + 5 * D + (size_t)hf * 2 * 6 * D, 6 * D, 0, l == NL - 1 ? 1 : 0};
                pg8::gemm_phase<pg8::EpiRes, pg8::StaticOrder, true, true>(ring, g, So, Ep, X.wave);
            } } else { if (st < 2) {
                const int hf = st; const size_t r0 = (size_t)hf * (M / 2);
                pg8::Gemm g{H + r0 * D, W1T + (size_t)l * FF * D, M / 2, FF, D}; pg8::StaticOrder So; So.init(M / 2, FF, X.G, (int)blockIdx.x, WGM_W1);
                pg8::EpiRelu2 Ep{(bf16*)BIG + (size_t)hf * (M / 2) * FF, FF};
                pg8::gemm_phase<pg8::EpiRelu2, pg8::StaticOrder, true, true>(ring, g, So, Ep, X.wave);
            } }
            if (sub == 0 && st == 1) { VM_WAIT(); __syncthreads(); }
            }
            if (l + 1 < NL || st < 2 || rep_ < REP_MLP - 1) GRID_BAR();
        }
#else
        _Pragma("unroll 1") for (int hf = 0; hf < 2; ++hf) {
            const size_t r0 = (size_t)hf * (M / 2);
            {
                pg8::Gemm g{H + r0 * D, W1T + (size_t)l * FF * D, M / 2, FF, D}; pg8::StaticOrder So; So.init(M / 2, FF, X.G, (int)blockIdx.x, WGM_W1);
                pg8::EpiRelu2 Ep{(bf16*)BIG, FF};
                _Pragma("unroll 1") for (int r2_ = 0; r2_ < REP_W1; ++r2_) {
                Ep.skip = (EPI_NULL && r2_ < REP_W1 - 1) ? 1 : 0;
                pg8::gemm_phase<pg8::EpiRelu2, pg8::StaticOrder, true, true>(ring, g, So, Ep, X.wave);
                GRID_BAR(); }
            }
            {
                pg8::Gemm g{(const bf16*)BIG, W2T + (size_t)l * D * FF, M / 2, D, FF}; pg8::StaticOrder So; So.init(M / 2, D, X.G, (int)blockIdx.x, WGM_W2);
                _Pragma("unroll 1") for (int r2_ = 0; r2_ < REP_W2; ++r2_) {
                pg8::EpiRes Ep{XH + r0 * D, XDST(rep_ == REP_MLP - 1 && r2_ == REP_W2 - 1), (MOD + (size_t)l * NB * 6 * D) + 5 * D + (size_t)hf * 2 * 6 * D, 6 * D, 0, l == NL - 1 ? 1 : 0};
                pg8::gemm_phase<pg8::EpiRes, pg8::StaticOrder, true, true>(ring, g, So, Ep, X.wave);
                if (l + 1 < NL || hf == 0 || rep_ < REP_MLP - 1 || r2_ < REP_W2 - 1) GRID_BAR(); }
            }
        }
#endif
        }
    }
    if (__hip_atomic_load(ctl + CW_BAR + XB_TMO, __ATOMIC_RELAXED, __HIP_MEMORY_SCOPE_AGENT) != 0u) {
        VM_WAIT(); __syncthreads();
        const float q = __builtin_nanf(""); const Ctx Xe = fresh(X);
        for (size_t i = (size_t)blockIdx.x * 512 + Xe.tid; i < (size_t)M * D; i += (size_t)X.G * 512) XOUT[i] = q;
    }
#undef GRID_BAR
}

extern "C" void kernel_launch(void* const* d_in, const int* in_sizes, int n_in, void* d_out, int out_size, void* d_ws, size_t ws_size, hipStream_t stream) {
    static int grid = 0;
    if (grid == 0) {
        if (n_in != 27 || in_sizes[0] != M * D || out_size != M * D || ws_size < WS_END) {
            fprintf(stderr, "kernel_launch: built for 27 inputs, x/out of %d floats, >= %zu bytes of workspace; got n_in %d, in0 %d, out %d, ws %zu; nothing launched\n", M * D, (size_t)WS_END, n_in, n_in > 0 ? in_sizes[0] : -1, out_size, ws_size);
            grid = -1; return; }
        int dev = 0, cus = 0, per_cu = 0;
        if (hipGetDevice(&dev) != hipSuccess || hipDeviceGetAttribute(&cus, hipDeviceAttributeMultiprocessorCount, dev) != hipSuccess) { fprintf(stderr, "kernel_launch: device query failed\n"); grid = -1; return; }
        if (hipFuncSetAttribute((const void*)fwd_kernel, hipFuncAttributeMaxDynamicSharedMemorySize, LDS_BYTES) != hipSuccess) { fprintf(stderr, "kernel_launch: hipFuncSetAttribute failed\n"); grid = -1; return; }
        if (hipOccupancyMaxActiveBlocksPerMultiprocessor(&per_cu, (const void*)fwd_kernel, NWAVES * 64, LDS_BYTES) != hipSuccess || per_cu < 1) {
            fprintf(stderr, "kernel_launch: occupancy query reports %d workgroups per CU for %d B of LDS; nothing launched\n", per_cu, LDS_BYTES); (void)hipGetLastError(); grid = -1; return; }
        grid = cus;
    }
    if (grid < 0) return;
    if (hipMemsetAsync((char*)d_ws + WS_CTL, 0, CTL_ZERO_BYTES, stream) != hipSuccess) { fprintf(stderr, "kernel_launch: memset failed\n"); return; }
    Args a{};
    for (int i = 0; i < 27; ++i) a.in[i] = d_in[i];
    a.out = (float*)d_out; a.ws = (unsigned char*)d_ws;
    hipLaunchKernelGGL(fwd_kernel, dim3(grid), dim3(NWAVES * 64), LDS_BYTES, stream, a);
    const hipError_t le = hipPeekAtLastError();
    if (le != hipSuccess) fprintf(stderr, "kernel_launch: launch failed: %s (grid %d)\n", hipGetErrorName(le), grid);
}
```

```cpp
#include <hip/hip_runtime.h>
#include <cstdio>
#include <cstdint>
#define WGM_QKV 4
#define WGM_S5U 4
#define WGM_OUT 4
#define WGM_GLU 4
#define WGM_W1 4
#define WGM_W2 4
#define REP_ATT_SB 1
#define REP_ATT_DSA 1
#define SB_STAG false
#define DSA_VARIANT 0
#define REP_LN 1
#define REP_IDX 1
#define REP_SEL 1
#define REP_CARRY 1
#define REP_MLP 1
#define MLP_VARIANT 1
#define REP_W1 1
#define REP_W2 1
#define REP_MOD 1
#define REP_TR 1
#define REP_PRO 1
#define REP_S5PRE 1
#define REP_QKV 1
#define EPI_NULL 0
#define REP_S5A 1
#define REP_S5B 1
#define REP_S5U 1
#define REP_OUT 1
#define LN_AHEAD 5
namespace pg8 {
#define PG8_LAS __attribute__((address_space(3)))
typedef unsigned short bf16_t;
typedef short bf16x8 __attribute__((ext_vector_type(8)));
typedef float f32x4 __attribute__((ext_vector_type(4)));
typedef unsigned u32x4 __attribute__((ext_vector_type(4)));
constexpr int BM = 256, BK = 64, HALF = 128, HTB = HALF * BK * 2  , STAGE_BYTES = 8 * HTB, NXCD = 8, WGM = 4;

__host__ __device__ __forceinline__ int lds_byte(int r, int c) { const int st = (r >> 4) * 2 + (c >> 5), rr = r & 15, cc = c & 31, ob = rr * 64 + cc * 2; return st * 1024 + (ob ^ (((ob >> 9) & 1) << 5)); }
__host__ __device__ __forceinline__ void stage_rc(int b, int& R, int& C) { const int st = b / 1024, sb = b % 1024, swz = sb ^ (((sb >> 9) & 1) << 5); R = (st >> 1) * 16 + swz / 64; C = (st & 1) * 32 + (swz % 64) / 2; }
__host__ __device__ __forceinline__ int perm32(int rho) { const int n = rho >> 4, i = rho & 15; return 8 * (i >> 2) + 4 * n + (i & 3); }

struct Unit { int pm, pn; };
struct Gemm { const bf16_t* A; const bf16_t* Bt; int M, N, K; int lda, ldb; };

struct StaticOrder {
    int nM, nN, nwg, G, c, wgm;
    __host__ __device__ void init(int M, int N, int G_, int c_, int wgm_ = WGM) { nM = M / BM; nN = N / BM; nwg = nM * nN; G = G_; c = c_; wgm = wgm_; }
    __host__ __device__ bool next(int i, Unit& u) const {
        const long L = (long)i * G + c; if (L >= nwg) return false;
        int wgid = (int)L; { const int q = nwg / NXCD, r = nwg % NXCD, xcd = wgid % NXCD, off = wgid / NXCD; wgid = (xcd < r ? xcd * (q + 1) : r * (q + 1) + (xcd - r) * q) + off; }
        const int nig = wgm * nN, gid = wgid / nig, fm = gid * wgm, gsz = (nM - fm) < wgm ? (nM - fm) : wgm;
        u.pm = fm + ((wgid % nig) % gsz); u.pn = (wgid % nig) / gsz; return true;
    }
    __device__ __forceinline__ void a_ready(const Unit&) const {}
    __device__ __forceinline__ void done(const Unit&) const {}
};
__device__ __forceinline__ unsigned cvt_pk_bf16(float lo, float hi) { unsigned r; asm volatile("v_cvt_pk_bf16_f32 %0, %1, %2" : "=v"(r) : "v"(lo), "v"(hi)); return r; }
typedef float f32x2 __attribute__((ext_vector_type(2)));
typedef unsigned u32x2 __attribute__((ext_vector_type(2)));
struct EpiF32 {
    static constexpr bool PERM = false, AFTER_DRAIN = false;
    float* C; int ldc;
    __device__ __forceinline__ void operator()(const f32x4 (&acc)[2][2][4][2], const Unit& u, int wr, int wc, int fr, int fq) const {
        const int row0 = u.pm * BM + wr * 64 + fr, col0 = u.pn * BM + wc * 32 + 4 * fq;
#pragma unroll
        for (int ai = 0; ai < 2; ++ai)
#pragma unroll
            for (int m = 0; m < 4; ++m) { float* rowp = C + (size_t)(row0 + ai * HALF + m * 16) * ldc + col0;
#pragma unroll
                for (int bj = 0; bj < 2; ++bj)
#pragma unroll
                    for (int n = 0; n < 2; ++n) *(f32x4*)(rowp + bj * HALF + n * 16) = acc[ai][bj][m][n]; }
    }
};
typedef _Float16 h16x8 __attribute__((ext_vector_type(8)));
typedef _Float16 h16x4 __attribute__((ext_vector_type(4)));
struct EpiRes {
    static constexpr bool PERM = true, AFTER_DRAIN = false;
    const void* base; void* out; const float* gate; int gpitch; int in_f32, out_f32;
    __device__ __forceinline__ void operator()(const f32x4 (&acc)[2][2][4][2], const Unit& u, int wr, int wc, int fr, int fq) const {
        const int row0 = u.pm * BM + wr * 64 + fr, col0 = u.pn * BM + wc * 32 + 8 * fq;
        const float* gp = gate + (size_t)(u.pm >> 4) * gpitch + col0;
        f32x4 gv[2][2];
#pragma unroll
        for (int bj = 0; bj < 2; ++bj)
#pragma unroll
            for (int n = 0; n < 2; ++n) gv[bj][n] = *(const f32x4*)(gp + bj * HALF + n * 4);
#pragma unroll
        for (int ai = 0; ai < 2; ++ai)
#pragma unroll
            for (int m = 0; m < 4; ++m) { const size_t off = (size_t)(row0 + ai * HALF + m * 16) * 2048 + col0;
#pragma unroll
                for (int bj = 0; bj < 2; ++bj) { f32x4 b0, b1;
                    if (in_f32) { b0 = *(const f32x4*)((const float*)base + off + bj * HALF); b1 = *(const f32x4*)((const float*)base + off + bj * HALF + 4); }
                    else { const h16x8 hv = *(const h16x8*)((const _Float16*)base + off + bj * HALF);
                        b0 = (f32x4){(float)hv[0], (float)hv[1], (float)hv[2], (float)hv[3]}; b1 = (f32x4){(float)hv[4], (float)hv[5], (float)hv[6], (float)hv[7]}; }
                    const f32x4 r0 = b0 + gv[bj][0] * acc[ai][bj][m][0], r1 = b1 + gv[bj][1] * acc[ai][bj][m][1];
                    if (out_f32) { *(f32x4*)((float*)out + off + bj * HALF) = r0; *(f32x4*)((float*)out + off + bj * HALF + 4) = r1; }
                    else { h16x8 o; o[0] = (_Float16)r0[0]; o[1] = (_Float16)r0[1]; o[2] = (_Float16)r0[2]; o[3] = (_Float16)r0[3]; o[4] = (_Float16)r1[0]; o[5] = (_Float16)r1[1]; o[6] = (_Float16)r1[2]; o[7] = (_Float16)r1[3];
                        *(h16x8*)((_Float16*)out + off + bj * HALF) = o; } }
                if (m == 3) asm volatile("" ::: "memory"); }
    }
};
struct EpiRelu2 {
    static constexpr bool PERM = true, AFTER_DRAIN = false;
    bf16_t* O; int ldc; int skip = 0;
    __device__ __forceinline__ void operator()(const f32x4 (&acc)[2][2][4][2], const Unit& u, int wr, int wc, int fr, int fq) const {
        if (skip) return;
        const int row0 = u.pm * BM + wr * 64 + fr, col0 = u.pn * BM + wc * 32 + 8 * fq;
#pragma unroll
        for (int ai = 0; ai < 2; ++ai)
#pragma unroll
            for (int m = 0; m < 4; ++m) { bf16_t* rowp = O + (size_t)(row0 + ai * HALF + m * 16) * ldc + col0;
#pragma unroll
                for (int bj = 0; bj < 2; ++bj) { f32x4 v0 = acc[ai][bj][m][0], v1 = acc[ai][bj][m][1];
#pragma unroll
                    for (int j = 0; j < 4; ++j) { const float a = fmaxf(v0[j], 0.f), b = fmaxf(v1[j], 0.f); v0[j] = a * a; v1[j] = b * b; }
                    u32x4 w; w.x = cvt_pk_bf16(v0[0], v0[1]); w.y = cvt_pk_bf16(v0[2], v0[3]); w.z = cvt_pk_bf16(v1[0], v1[1]); w.w = cvt_pk_bf16(v1[2], v1[3]);
                    *(u32x4*)(rowp + bj * HALF) = w; } }
    }
};
struct EpiBf16Plain {
    static constexpr bool PERM = true, AFTER_DRAIN = false;
    bf16_t* O; int ldc;
    __device__ __forceinline__ void operator()(const f32x4 (&acc)[2][2][4][2], const Unit& u, int wr, int wc, int fr, int fq) const {
        const int row0 = u.pm * BM + wr * 64 + fr, col0 = u.pn * BM + wc * 32 + 8 * fq;
#pragma unroll
        for (int ai = 0; ai < 2; ++ai)
#pragma unroll
            for (int m = 0; m < 4; ++m) { bf16_t* rowp = O + (size_t)(row0 + ai * HALF + m * 16) * ldc + col0;
#pragma unroll
                for (int bj = 0; bj < 2; ++bj) { const f32x4 v0 = acc[ai][bj][m][0], v1 = acc[ai][bj][m][1];
                    u32x4 w; w.x = cvt_pk_bf16(v0[0], v0[1]); w.y = cvt_pk_bf16(v0[2], v0[3]); w.z = cvt_pk_bf16(v1[0], v1[1]); w.w = cvt_pk_bf16(v1[2], v1[3]);
                    *(u32x4*)(rowp + bj * HALF) = w; } }
    }
};
struct EpiGluRes {
    static constexpr bool PERM = true, AFTER_DRAIN = false;
    const _Float16* base; _Float16* out; const float* gate; int gpitch;
    __device__ __forceinline__ void operator()(const f32x4 (&acc)[2][2][4][2], const Unit& u, int wr, int wc, int fr, int fq) const {
        const int row0 = u.pm * BM + wr * 64 + fr, col0 = u.pn * HALF + wc * 32 + 8 * fq;
        const float* gp = gate + (size_t)(u.pm >> 4) * gpitch + col0;
        f32x4 gv[2];
#pragma unroll
        for (int n = 0; n < 2; ++n) gv[n] = *(const f32x4*)(gp + n * 4);
#pragma unroll
        for (int ai = 0; ai < 2; ++ai)
#pragma unroll
            for (int m = 0; m < 4; ++m) { const size_t off = (size_t)(row0 + ai * HALF + m * 16) * 2048 + col0;
                const h16x8 hv = *(const h16x8*)(base + off); h16x8 o;
#pragma unroll
                for (int n = 0; n < 2; ++n) { const f32x4 bs = {(float)hv[4 * n], (float)hv[4 * n + 1], (float)hv[4 * n + 2], (float)hv[4 * n + 3]};
                    const f32x4 a = acc[ai][0][m][n], g = acc[ai][1][m][n]; f32x4 y;
#pragma unroll
                    for (int j = 0; j < 4; ++j) y[j] = a[j] * __builtin_amdgcn_rcpf(1.0f + __builtin_amdgcn_exp2f(-1.4426950408889634f * g[j]));
                    const f32x4 r = bs + gv[n] * y; o[4 * n] = (_Float16)r[0]; o[4 * n + 1] = (_Float16)r[1]; o[4 * n + 2] = (_Float16)r[2]; o[4 * n + 3] = (_Float16)r[3]; }
                *(h16x8*)(out + off) = o;
                if (m == 3) asm volatile("" ::: "memory"); }
    }
};
struct GroupOrder {
    int G, c;
    __device__ __forceinline__ bool next(int i, Unit& u) const { const int L = i * G + c; if (L >= 512) return false; u.pm = L; u.pn = L >> 2; return true; }
    __device__ __forceinline__ void a_ready(const Unit&) const {}
    __device__ __forceinline__ void done(const Unit&) const {}
};
struct EpiS5U {
    static constexpr bool PERM = true, AFTER_DRAIN = false;
    bf16_t* AG;
    __device__ __forceinline__ void operator()(const f32x4 (&acc)[2][2][4][2], const Unit& u, int wr, int wc, int fr, int fq) const {
        const int row0 = u.pm * BM + wr * 64 + fr, col0 = u.pn * BM + wc * 32 + 8 * fq;
#pragma unroll
        for (int ai = 0; ai < 2; ++ai)
#pragma unroll
            for (int m = 0; m < 4; ++m) { const int row = row0 + ai * HALF + m * 16, rb = (row >> 12) * 256 + ((row & 4095) >> 4), tl = row & 15;
#pragma unroll
                for (int bj = 0; bj < 2; ++bj) { const int col = col0 + bj * HALF, g = col >> 4, c0 = col & 15; const f32x4 v0 = acc[ai][bj][m][0], v1 = acc[ai][bj][m][1];
                    u32x4 w; w.x = cvt_pk_bf16(v0[0], v0[1]); w.y = cvt_pk_bf16(v0[2], v0[3]); w.z = cvt_pk_bf16(v1[0], v1[1]); w.w = cvt_pk_bf16(v1[2], v1[3]);
                    *(u32x4*)(AG + ((size_t)(g * 1024 + rb) * 384 + tl * 16 + c0)) = w; } }
    }
};
struct EpiS5E {
    static constexpr bool PERM = true, AFTER_DRAIN = false;
    float* E;
    __device__ __forceinline__ void operator()(const f32x4 (&acc)[2][2][4][2], const Unit& u, int wr, int wc, int fr, int fq) const {
        const int row0 = u.pm * BM + wr * 64 + fr, col0 = wc * 32 + 8 * fq;
#pragma unroll
        for (int ai = 0; ai < 2; ++ai)
#pragma unroll
            for (int m = 0; m < 4; ++m) { float* rowp = E + (size_t)(row0 + ai * HALF + m * 16) * 128 + col0;
#pragma unroll
                for (int n = 0; n < 2; ++n) *(f32x4*)(rowp + n * 4) = acc[ai][0][m][n]; }
    }
};
struct EpiS5Out {
    static constexpr bool PERM = true, AFTER_DRAIN = false;
    __amdgpu_buffer_rsrc_t rAG, rZG, rD;
    __device__ __forceinline__ void operator()(const f32x4 (&acc)[2][2][4][2], const Unit& u, int wr, int wc, int, int) const {
        int ln; asm volatile("v_mbcnt_lo_u32_b32 %0, -1, 0\n\tv_mbcnt_hi_u32_b32 %0, -1, %0" : "=v"(ln));
        const int fr = ln & 15, fq = ln >> 4;
        const int col0 = wc * 32 + 8 * fq;
        const unsigned rowb = (unsigned)(u.pm * BM + wr * 64 + fr);
        const unsigned dof = (unsigned)(u.pn * 16 + 8 * (fq & 1)) * 4u;
        const f32x4 d0 = __builtin_bit_cast(f32x4, __builtin_amdgcn_raw_buffer_load_b128(rD, dof, 0, 0)), d1 = __builtin_bit_cast(f32x4, __builtin_amdgcn_raw_buffer_load_b128(rD, dof + 16u, 0, 0));
#pragma unroll
        for (int ai = 0; ai < 2; ++ai)
#pragma unroll
            for (int m = 0; m < 4; ++m) { const unsigned row = rowb + (unsigned)(ai * HALF + m * 16);
#pragma unroll
                for (int bj = 0; bj < 2; ++bj) { const int n0 = col0 + bj * HALF;
                    const u32x4 uv = __builtin_bit_cast(u32x4, __builtin_amdgcn_raw_buffer_load_b128(rAG, (row * 384u + (unsigned)n0) * 2u, 0, 0));
                    const unsigned ux = uv[0], uy = uv[1], uz = uv[2], uw = uv[3];
                    f32x4 y0 = acc[ai][bj][m][0], y1 = acc[ai][bj][m][1];
                    y0[0] += d0[0] * __builtin_bit_cast(float, ux << 16); y0[1] += d0[1] * __builtin_bit_cast(float, ux & 0xffff0000u);
                    y0[2] += d0[2] * __builtin_bit_cast(float, uy << 16); y0[3] += d0[3] * __builtin_bit_cast(float, uy & 0xffff0000u);
                    y1[0] += d1[0] * __builtin_bit_cast(float, uz << 16); y1[1] += d1[1] * __builtin_bit_cast(float, uz & 0xffff0000u);
                    y1[2] += d1[2] * __builtin_bit_cast(float, uw << 16); y1[3] += d1[3] * __builtin_bit_cast(float, uw & 0xffff0000u);
#pragma unroll
                    for (int j = 0; j < 4; ++j) {
                        { const float y = y0[j], a2 = 1.5957691216057308f * (y + 0.044715f * y * y * y); y0[j] = y * __builtin_amdgcn_rcpf(1.0f + __builtin_amdgcn_exp2f(-1.4426950408889634f * a2)); }
                        { const float y = y1[j], a2 = 1.5957691216057308f * (y + 0.044715f * y * y * y); y1[j] = y * __builtin_amdgcn_rcpf(1.0f + __builtin_amdgcn_exp2f(-1.4426950408889634f * a2)); } }
                    u32x4 w; w.x = cvt_pk_bf16(y0[0], y0[1]); w.y = cvt_pk_bf16(y0[2], y0[3]); w.z = cvt_pk_bf16(y1[0], y1[1]); w.w = cvt_pk_bf16(y1[2], y1[3]);
                    __builtin_amdgcn_raw_buffer_store_b128(w, rZG, (row * 256u + (unsigned)n0) * 2u, 0, 0); } }
    }
};
struct EpiQkv {
    static constexpr bool PERM = false, AFTER_DRAIN = false;
    bf16_t* QN; bf16_t* KN; bf16_t* VN; bf16_t* QI; bf16_t* KI; float* WI;
    const float* gq; const float* gk; const float* CS; const float* CS2; int dsa; float QS, eps;
    PG8_LAS float* P;
    int skip = 0;
    __device__ __forceinline__ static unsigned long long pk4(const f32x4 v) { return (unsigned long long)cvt_pk_bf16(v[0], v[1]) | ((unsigned long long)cvt_pk_bf16(v[2], v[3]) << 32); }
    __device__ __forceinline__ void operator()(const f32x4 (&acc)[2][2][4][2], const Unit& u, int wr, int wc, int fr, int fq) const {
        if (skip) return;
        const int row0 = u.pm * BM + wr * 64 + fr, lrow0 = wr * 64 + fr, sec = u.pn >> 3;
        if (sec < 2 && dsa) {
            const int xidx = ((fr + 16 * fq) ^ 32) << 2, hd = wc >> 1;
#pragma unroll
            for (int ai = 0; ai < 2; ++ai)
#pragma unroll
                for (int m = 0; m < 4; ++m) { float ss = 0.f;
#pragma unroll
                    for (int bj = 0; bj < 2; ++bj) { const f32x4 a = acc[ai][bj][m][0], b = acc[ai][bj][m][1];
                        ss += ((a[0] * a[0] + a[1] * a[1]) + (a[2] * a[2] + a[3] * a[3])) + ((b[0] * b[0] + b[1] * b[1]) + (b[2] * b[2] + b[3] * b[3])); }
                    ss += __builtin_bit_cast(float, (unsigned)__builtin_amdgcn_ds_swizzle(__builtin_bit_cast(int, ss), (16 << 10) | 0x1F));
                    ss += __builtin_bit_cast(float, __builtin_amdgcn_ds_bpermute(xidx, __builtin_bit_cast(int, ss)));
                    if (fq == 0) P[((ai * HALF + lrow0 + m * 16) * 2 + hd) * 2 + (wc & 1)] = ss; }
            asm volatile("s_waitcnt lgkmcnt(0)" ::: "memory"); __builtin_amdgcn_s_barrier(); asm volatile("" ::: "memory");
            int d0 = 32 * (wc & 1) + 8 * fq; asm volatile("" : "+v"(d0));
            const float* gp = sec ? gk : gq;
            const f32x4 ga0 = *(const f32x4*)(gp + d0), ga1 = *(const f32x4*)(gp + d0 + 4), gb0 = *(const f32x4*)(gp + 64 + d0), gb1 = *(const f32x4*)(gp + 68 + d0);
            bf16_t* dst = (sec ? KN : QN) + (size_t)((u.pn & 7) * 2 + hd) * 128 + d0; const float qs = sec ? 1.0f : QS;
#pragma unroll
            for (int ai = 0; ai < 2; ++ai)
#pragma unroll
                for (int m = 0; m < 4; ++m) { const int lrow = ai * HALF + lrow0 + m * 16; const size_t row = (size_t)(row0 + ai * HALF + m * 16);
                    const float* cp = CS + row * 128 + d0;
                    const f32x4 cs0 = *(const f32x4*)cp, cs1 = *(const f32x4*)(cp + 4), sn0 = *(const f32x4*)(cp + 64), sn1 = *(const f32x4*)(cp + 68);
                    const float p0 = P[(lrow * 2 + hd) * 2], p1 = P[(lrow * 2 + hd) * 2 + 1];
                    const float r = qs * __builtin_amdgcn_rsqf((p0 + p1) * (1.0f / 128.0f) + eps);
                    const f32x4 ya0 = acc[ai][0][m][0] * r * ga0, ya1 = acc[ai][0][m][1] * r * ga1, yb0 = acc[ai][1][m][0] * r * gb0, yb1 = acc[ai][1][m][1] * r * gb1;
                    const f32x4 oa0 = ya0 * cs0 - yb0 * sn0, oa1 = ya1 * cs1 - yb1 * sn1, ob0 = yb0 * cs0 + ya0 * sn0, ob1 = yb1 * cs1 + ya1 * sn1;
                    u32x4 wa, wb; wa.x = cvt_pk_bf16(oa0[0], oa0[1]); wa.y = cvt_pk_bf16(oa0[2], oa0[3]); wa.z = cvt_pk_bf16(oa1[0], oa1[1]); wa.w = cvt_pk_bf16(oa1[2], oa1[3]);
                    wb.x = cvt_pk_bf16(ob0[0], ob0[1]); wb.y = cvt_pk_bf16(ob0[2], ob0[3]); wb.z = cvt_pk_bf16(ob1[0], ob1[1]); wb.w = cvt_pk_bf16(ob1[2], ob1[3]);
                    *(u32x4*)(dst + row * 2048) = wa; *(u32x4*)(dst + row * 2048 + 64) = wb; }
        } else if (sec < 2) {
            const int xidx = ((fr + 16 * fq) ^ 32) << 2;
#pragma unroll
            for (int ai = 0; ai < 2; ++ai)
#pragma unroll
                for (int m = 0; m < 4; ++m)
#pragma unroll
                    for (int bj = 0; bj < 2; ++bj) { const f32x4 a = acc[ai][bj][m][0], b = acc[ai][bj][m][1];
                        float ss = ((a[0] * a[0] + a[1] * a[1]) + (a[2] * a[2] + a[3] * a[3])) + ((b[0] * b[0] + b[1] * b[1]) + (b[2] * b[2] + b[3] * b[3]));
                        ss += __builtin_bit_cast(float, (unsigned)__builtin_amdgcn_ds_swizzle(__builtin_bit_cast(int, ss), (16 << 10) | 0x1F));
                        ss += __builtin_bit_cast(float, __builtin_amdgcn_ds_bpermute(xidx, __builtin_bit_cast(int, ss)));
                        if (fq == 0) P[((ai * HALF + lrow0 + m * 16) * 2 + bj) * 4 + wc] = ss; }
            asm volatile("s_waitcnt lgkmcnt(0)" ::: "memory"); __builtin_amdgcn_s_barrier(); asm volatile("" ::: "memory");
            int d0 = 32 * wc + 8 * fq; asm volatile("" : "+v"(d0));
            const float* gp = sec ? gk : gq;
            const f32x4 h0 = *(const f32x4*)(gp + d0), h1 = *(const f32x4*)(gp + d0 + 4);
            bf16_t* dst = (sec ? KN : QN) + (size_t)(u.pn & 7) * 256 + d0; const float qs = sec ? 1.0f : QS;
#pragma unroll
            for (int ai = 0; ai < 2; ++ai)
#pragma unroll
                for (int m = 0; m < 4; ++m) { const int lrow = ai * HALF + lrow0 + m * 16; const size_t row = (size_t)(row0 + ai * HALF + m * 16);
#pragma unroll
                    for (int bj = 0; bj < 2; ++bj) { const f32x4 pp = *(const PG8_LAS f32x4*)(P + (lrow * 2 + bj) * 4);
                        const float r = qs * __builtin_amdgcn_rsqf(((pp[0] + pp[1]) + (pp[2] + pp[3])) * (1.0f / 128.0f) + eps);
                        const f32x4 y0 = acc[ai][bj][m][0] * r * h0, y1 = acc[ai][bj][m][1] * r * h1;
                        u32x4 w; w.x = cvt_pk_bf16(y0[0], y0[1]); w.y = cvt_pk_bf16(y0[2], y0[3]); w.z = cvt_pk_bf16(y1[0], y1[1]); w.w = cvt_pk_bf16(y1[2], y1[3]);
                        *(u32x4*)(dst + row * 2048 + bj * 128) = w; } }
        } else if (sec == 2) {
            bf16_t* dst = VN + (size_t)(u.pn & 7) * 256 + 32 * wc + 8 * fq;
#pragma unroll
            for (int ai = 0; ai < 2; ++ai)
#pragma unroll
                for (int m = 0; m < 4; ++m) { const size_t row = (size_t)(row0 + ai * HALF + m * 16);
#pragma unroll
                    for (int bj = 0; bj < 2; ++bj) { const f32x4 v0 = acc[ai][bj][m][0], v1 = acc[ai][bj][m][1];
                        u32x4 w; w.x = cvt_pk_bf16(v0[0], v0[1]); w.y = cvt_pk_bf16(v0[2], v0[3]); w.z = cvt_pk_bf16(v1[0], v1[1]); w.w = cvt_pk_bf16(v1[2], v1[3]);
                        *(u32x4*)(dst + row * 2048 + bj * 128) = w; } }
        } else if (u.pn < 28) {
            const int d0 = 8 * fq;
#pragma unroll
            for (int ai = 0; ai < 2; ++ai)
#pragma unroll
                for (int m = 0; m < 4; ++m) { const size_t row = (size_t)(row0 + ai * HALF + m * 16);
                    const float* cp = CS2 + row * 64 + d0;
                    const f32x4 cs0 = *(const f32x4*)cp, cs1 = *(const f32x4*)(cp + 4), sn0 = *(const f32x4*)(cp + 32), sn1 = *(const f32x4*)(cp + 36);
                    const f32x4 ya0 = acc[ai][0][m][0], ya1 = acc[ai][0][m][1], yb0 = acc[ai][1][m][0], yb1 = acc[ai][1][m][1];
                    const f32x4 oa0 = ya0 * cs0 - yb0 * sn0, oa1 = ya1 * cs1 - yb1 * sn1, ob0 = yb0 * cs0 + ya0 * sn0, ob1 = yb1 * cs1 + ya1 * sn1;
                    u32x4 wa, wb; wa.x = cvt_pk_bf16(oa0[0], oa0[1]); wa.y = cvt_pk_bf16(oa0[2], oa0[3]); wa.z = cvt_pk_bf16(oa1[0], oa1[1]); wa.w = cvt_pk_bf16(oa1[2], oa1[3]);
                    wb.x = cvt_pk_bf16(ob0[0], ob0[1]); wb.y = cvt_pk_bf16(ob0[2], ob0[3]); wb.z = cvt_pk_bf16(ob1[0], ob1[1]); wb.w = cvt_pk_bf16(ob1[2], ob1[3]);
                    bf16_t* dp = QI + row * 1024 + (size_t)(4 * (u.pn - 24) + wc) * 64 + d0;
                    *(u32x4*)dp = wa; *(u32x4*)(dp + 32) = wb; }
        } else {
            const int d0 = 16 * (wc & 1) + 4 * fq;
#pragma unroll
            for (int ai = 0; ai < 2; ++ai)
#pragma unroll
                for (int m = 0; m < 4; ++m) { const size_t row = (size_t)(row0 + ai * HALF + m * 16);
                    if (wc < 2) { const f32x4 cs = *(const f32x4*)(CS2 + row * 64 + d0), sn = *(const f32x4*)(CS2 + row * 64 + 32 + d0);
                        const f32x4 y0 = acc[ai][0][m][0], y1 = acc[ai][0][m][1]; const f32x4 o0 = y0 * cs - y1 * sn, o1 = y1 * cs + y0 * sn;
                        bf16_t* dp = KI + row * 64 + d0; *(unsigned long long*)dp = pk4(o0); *(unsigned long long*)(dp + 32) = pk4(o1); }
                    else if (wc == 2) *(f32x4*)(WI + row * 16 + 4 * fq) = acc[ai][0][m][0] * (0.25f * 0.125f); }
        }
    }
};
template <class Epi, class Sched, bool ALIGN_EPI = false, bool SP2 = false, bool AGRP = false  >
__device__ __forceinline__ void gemm_phase(PG8_LAS unsigned char* lds, const Gemm g, const Sched& S, const Epi& E, int wid_in  ) {
    int lane_; asm volatile("v_mbcnt_lo_u32_b32 %0, -1, 0\n\tv_mbcnt_hi_u32_b32 %0, -1, %0" : "=v"(lane_));
    const int wid = wid_in, tid = wid * 64 + lane_, lane = lane_, wr = wid >> 2, wc = wid & 3, fr = lane & 15, fq = lane >> 4;
    const int K = g.K, nt = K / BK, lda = g.lda ? g.lda : K, ldb = g.ldb ? g.ldb : K;
    unsigned voffA[2], voffB[2];
#pragma unroll
    for (int i = 0; i < 2; ++i) { int R, C; stage_rc(tid * 16 + i * 8192, R, C); const int Rb = Epi::PERM ? ((R & ~31) + perm32(R & 31)) : R;
        voffA[i] = AGRP ? (unsigned)((C >> 4) * (g.M * 16) + R * 16 + (C & 15)) * 2u : (unsigned)(R * lda + C) * 2u; voffB[i] = (unsigned)(Rb * ldb + C) * 2u; }
    const size_t kstepA = AGRP ? (size_t)4 * g.M * 16 * 2 : (size_t)(BK * 2), kstepB = (size_t)(BK * 2);
    const size_t hstepA = AGRP ? (size_t)HALF * 16 * 2 : (size_t)HALF * lda * 2, hstepB = (size_t)HALF * ldb * 2;
    const size_t tstepA = 2 * hstepA, tstepB = 2 * hstepB;
    const unsigned ldsw = (unsigned)wid * 1024u;
    const int aoff = lds_byte(wr * 64 + fr, fq * 8), boff = lds_byte(wc * 32 + fr, fq * 8);
#define PG8_SA(b, h) (((b) * 2 + (h)) * HTB)
#define PG8_SB(b, h) ((4 + (b) * 2 + (h)) * HTB)
#define PG8_STAGE(bufoff, gbase, voff) do { _Pragma("unroll") for (int _i = 0; _i < 2; ++_i) \
        __builtin_amdgcn_global_load_lds((const unsigned*)((const char*)(gbase) + (voff)[_i]), (PG8_LAS unsigned*)(lds + (bufoff) + ldsw + _i * 8192), 16, 0, 0); } while (0)
#define PG8_LDA(dst, b, h) do { _Pragma("unroll") for (int m = 0; m < 4; ++m) _Pragma("unroll") for (int k = 0; k < 2; ++k) dst[m][k] = *(const PG8_LAS bf16x8*)(lds + PG8_SA(b, h) + aoff + m * 2048 + k * 1024); } while (0)
#define PG8_LDB(dst, b, h) do { _Pragma("unroll") for (int n = 0; n < 2; ++n) _Pragma("unroll") for (int k = 0; k < 2; ++k) dst[n][k] = *(const PG8_LAS bf16x8*)(lds + PG8_SB(b, h) + boff + n * 2048 + k * 1024); } while (0)
#define PG8_MMA(ai, bj, At, Bt) do { __builtin_amdgcn_s_setprio(1); _Pragma("unroll") for (int m = 0; m < 4; ++m) _Pragma("unroll") for (int n = 0; n < 2; ++n) _Pragma("unroll") for (int k = 0; k < 2; ++k) \
        acc[ai][bj][m][n] = __builtin_amdgcn_mfma_f32_16x16x32_bf16(Bt[n][k], At[m][k], acc[ai][bj][m][n], 0, 0, 0); __builtin_amdgcn_s_setprio(0); } while (0)
#define PG8_WAIT_V(n) asm volatile("s_waitcnt vmcnt(" #n ")" ::: "memory")
#define PG8_WAIT_L(n) asm volatile("s_waitcnt lgkmcnt(" #n ")" ::: "memory")
#define PG8_BAR __builtin_amdgcn_s_barrier()
#define PG8_SCHED __builtin_amdgcn_sched_barrier(0)
    Unit cur, nxt; int ui = 0;
    if (!S.next(0, cur)) return;
    f32x4 acc[2][2][4][2];
#pragma unroll
    for (int a = 0; a < 2; ++a)
#pragma unroll
        for (int b = 0; b < 2; ++b)
#pragma unroll
            for (int m = 0; m < 4; ++m)
#pragma unroll
                for (int n = 0; n < 2; ++n) acc[a][b][m][n] = (f32x4){0.f, 0.f, 0.f, 0.f};
    bf16x8 At[4][2], B0[2][2], B1[2][2];
    const char* cA = (const char*)g.A + (size_t)cur.pm * tstepA; const char* cB = (const char*)g.Bt + (size_t)cur.pn * tstepB;
    S.a_ready(cur);
    if constexpr (SP2) {
        PG8_STAGE(PG8_SB(0, 0), cB, voffB); PG8_STAGE(PG8_SB(0, 1), cB + hstepB, voffB); PG8_STAGE(PG8_SA(0, 0), cA, voffA); PG8_STAGE(PG8_SA(0, 1), cA + hstepA, voffA);
        if (wr == 1) PG8_BAR;
        PG8_WAIT_V(2); PG8_BAR;
        PG8_STAGE(PG8_SB(1, 0), cB + kstepB, voffB); PG8_STAGE(PG8_SA(1, 0), cA + kstepA, voffA); PG8_STAGE(PG8_SB(1, 1), cB + hstepB + kstepB, voffB);
        PG8_WAIT_V(6); PG8_BAR;
    } else {
        PG8_STAGE(PG8_SB(0, 0), cB, voffB); PG8_STAGE(PG8_SA(0, 0), cA, voffA); PG8_STAGE(PG8_SB(0, 1), cB + hstepB, voffB); PG8_STAGE(PG8_SA(0, 1), cA + hstepA, voffA);
        if (wr == 1) PG8_BAR;
        PG8_WAIT_V(4); PG8_BAR;
        PG8_STAGE(PG8_SB(1, 0), cB + kstepB, voffB); PG8_STAGE(PG8_SA(1, 0), cA + kstepA, voffA); PG8_STAGE(PG8_SB(1, 1), cB + hstepB + kstepB, voffB);
        PG8_WAIT_V(6); PG8_BAR;
    }
    for (;;) {
        const bool has_next = S.next(ui + 1, nxt);
        const char* nA = has_next ? (const char*)g.A + (size_t)nxt.pm * tstepA : cA; const char* nB = has_next ? (const char*)g.Bt + (size_t)nxt.pn * tstepB : cB;
        for (int t = 0; t < nt; t += 2) {
            const bool last = (t == nt - 2);
            const char* a1 = cA + (size_t)(t + 1) * kstepA;
            const char* a2 = last ? nA : cA + (size_t)(t + 2) * kstepA; const char* b2 = last ? nB : cB + (size_t)(t + 2) * kstepB;
            const char* a3 = a2 + kstepA; const char* b3 = b2 + kstepB;
            if (last && has_next) S.a_ready(nxt);
            if constexpr (SP2) {
            PG8_LDB(B0, 0, 0); PG8_LDB(B1, 0, 1); PG8_SCHED; PG8_LDA(At, 0, 0); PG8_STAGE(PG8_SA(1, 1), a1 + hstepA, voffA);
            PG8_WAIT_V(8); PG8_WAIT_L(0); PG8_BAR; PG8_MMA(0, 0, At, B0); PG8_MMA(0, 1, At, B1); PG8_BAR; PG8_SCHED;
            PG8_LDA(At, 0, 1); PG8_STAGE(PG8_SB(0, 0), b2, voffB); PG8_STAGE(PG8_SB(0, 1), b2 + hstepB, voffB); PG8_STAGE(PG8_SA(0, 0), a2, voffA);
            PG8_WAIT_V(8); PG8_WAIT_L(0); PG8_BAR; PG8_MMA(1, 0, At, B0); PG8_MMA(1, 1, At, B1); PG8_BAR; PG8_SCHED;
            PG8_LDB(B0, 1, 0); PG8_LDB(B1, 1, 1); PG8_SCHED; PG8_LDA(At, 1, 0); PG8_STAGE(PG8_SA(0, 1), a2 + hstepA, voffA);
            PG8_WAIT_V(8); PG8_WAIT_L(0); PG8_BAR; PG8_MMA(0, 0, At, B0); PG8_MMA(0, 1, At, B1); PG8_BAR; PG8_SCHED;
            PG8_LDA(At, 1, 1); PG8_STAGE(PG8_SB(1, 0), b3, voffB); PG8_STAGE(PG8_SB(1, 1), b3 + hstepB, voffB); PG8_STAGE(PG8_SA(1, 0), a3, voffA);
            PG8_WAIT_V(8); PG8_WAIT_L(0); PG8_BAR; PG8_MMA(1, 0, At, B0); PG8_MMA(1, 1, At, B1); PG8_BAR; PG8_SCHED;
            } else {
            PG8_LDB(B0, 0, 0); PG8_SCHED; PG8_LDA(At, 0, 0); PG8_STAGE(PG8_SA(1, 1), a1 + hstepA, voffA);
            PG8_WAIT_L(8); PG8_BAR; PG8_WAIT_L(0); PG8_MMA(0, 0, At, B0); PG8_BAR; PG8_SCHED;
            PG8_LDB(B1, 0, 1); PG8_STAGE(PG8_SB(0, 0), b2, voffB);
            PG8_BAR; PG8_WAIT_L(0); PG8_MMA(0, 1, At, B1); PG8_BAR;
            PG8_LDA(At, 0, 1); PG8_STAGE(PG8_SA(0, 0), a2, voffA);
            PG8_BAR; PG8_WAIT_L(0); PG8_MMA(1, 0, At, B0); PG8_BAR; PG8_SCHED;
            PG8_STAGE(PG8_SB(0, 1), b2 + hstepB, voffB);
            PG8_WAIT_V(6); PG8_BAR; PG8_MMA(1, 1, At, B1); PG8_BAR;
            PG8_LDB(B0, 1, 0); PG8_SCHED; PG8_LDA(At, 1, 0); PG8_STAGE(PG8_SA(0, 1), a2 + hstepA, voffA);
            PG8_WAIT_L(8); PG8_BAR; PG8_WAIT_L(0); PG8_MMA(0, 0, At, B0); PG8_BAR; PG8_SCHED;
            PG8_LDB(B1, 1, 1); PG8_STAGE(PG8_SB(1, 0), b3, voffB);
            PG8_BAR; PG8_WAIT_L(0); PG8_MMA(0, 1, At, B1); PG8_BAR;
            PG8_LDA(At, 1, 1); PG8_STAGE(PG8_SA(1, 0), a3, voffA);
            PG8_BAR; PG8_WAIT_L(0); PG8_MMA(1, 0, At, B0); PG8_BAR; PG8_SCHED;
            PG8_STAGE(PG8_SB(1, 1), b3 + hstepB, voffB);
            PG8_WAIT_V(6); PG8_BAR; PG8_MMA(1, 1, At, B1); PG8_BAR;
            }
        }
        if constexpr (ALIGN_EPI) { if (wr == 0) PG8_BAR; }
        if constexpr (!Epi::AFTER_DRAIN) { E(acc, cur, wr, wc, fr, fq); S.done(cur); }
        if (!has_next) break;
#pragma unroll
        for (int a = 0; a < 2; ++a)
#pragma unroll
            for (int b = 0; b < 2; ++b)
#pragma unroll
                for (int m = 0; m < 4; ++m)
#pragma unroll
                    for (int n = 0; n < 2; ++n) acc[a][b][m][n] = (f32x4){0.f, 0.f, 0.f, 0.f};
        cur = nxt; cA = nA; cB = nB; ++ui;
        if constexpr (ALIGN_EPI) { if (wr == 1) PG8_BAR; }
    }
    PG8_WAIT_V(0);
    if constexpr (!ALIGN_EPI) { if (wr == 0) PG8_BAR; }
    PG8_BAR;
    if constexpr (Epi::AFTER_DRAIN) { E.fused(acc, cur, wr, wc, fr, fq, lds, wid, lane); S.done(cur); }
#undef PG8_SA
#undef PG8_SB
#undef PG8_STAGE
#undef PG8_LDA
#undef PG8_LDB
#undef PG8_MMA
#undef PG8_WAIT_V
#undef PG8_WAIT_L
#undef PG8_BAR
#undef PG8_SCHED
}
}
constexpr int NB = 4, S = 4096, D = 2048, M = NB * S, FF = 8192, NH = 16, HD = 128, NL = 4;
constexpr int G5 = 128, P5 = 64, C5 = 16;
constexpr int DSA_N = 7248, DSA_NP = 7424, TOPK = 256;
constexpr float EPS = 1e-6f;
constexpr float QSCALE = 0.08838834764831845f * 1.4426950408889634f;
constexpr int NWAVES = 8;

constexpr size_t MiB = 1u << 20;
constexpr size_t WS_CTL = 0, CTL_ZERO_BYTES = 1 * MiB;
constexpr size_t WS_MOD = 2 * MiB;
constexpr size_t WS_S5C = 3 * MiB;
constexpr size_t WS_W1T = 8 * MiB;
constexpr size_t WS_W2T = WS_W1T + 128 * MiB;
constexpr size_t WS_SBIN = WS_W2T + 128 * MiB;
constexpr size_t WS_SBOUT = WS_SBIN + 48 * MiB;
constexpr size_t WS_S5IN = WS_SBOUT + 16 * MiB;
constexpr size_t WS_S5GLU = WS_S5IN + 8 * MiB;
constexpr size_t WS_DSAIN = WS_S5GLU + 16 * MiB;
constexpr size_t WS_DSAOUT = WS_DSAIN + 29 * MiB;
constexpr size_t WS_H = WS_DSAOUT + 8 * MiB + 3 * MiB;
constexpr size_t WS_BIG = WS_H + 64 * MiB;
constexpr size_t WS_QN = WS_BIG + 464 * MiB, WS_KN = WS_QN + 64 * MiB, WS_VN = WS_KN + 64 * MiB, WS_O = WS_VN + 64 * MiB;
constexpr size_t WS_QI = WS_O + 64 * MiB;
constexpr size_t WS_CS = WS_QI + 32 * MiB, WS_CS2 = WS_QI + 40 * MiB;
constexpr size_t WS_KI = WS_QI + 64 * MiB;
constexpr size_t WS_WI = WS_KI + 4 * MiB;
constexpr size_t WS_BITS = WS_WI + 1 * MiB;
constexpr size_t WS_B1 = WS_BITS + 8 * MiB;
constexpr size_t WS_B3 = WS_B1 + 16 * MiB;
constexpr size_t WS_END = WS_B3 + 24 * MiB;
constexpr size_t WS_AG = WS_BIG;
constexpr size_t WS_XH = WS_BIG + 384 * MiB;
constexpr size_t WS_E = WS_BIG + 96 * MiB;
static_assert((size_t)DSA_NP * D * 2 == 29 * MiB && (size_t)M * DSA_NP * 4 == 464 * MiB, "ws map");
constexpr int CW_TMO = 0, CW_BAR = 4096;

constexpr int RING_OFF = 0, RING_BYTES = 131072;
constexpr int LDSCTL_OFF = RING_BYTES, MISC_OFF = LDSCTL_OFF + 320;
constexpr int EPI_OFF = RING_BYTES + 512;
constexpr int LDS_BYTES = 147456;

#define GAS __attribute__((address_space(1)))
#define LAS __attribute__((address_space(3)))
typedef unsigned short bf16;
typedef unsigned v4u __attribute__((ext_vector_type(4)));
typedef unsigned v2u __attribute__((ext_vector_type(2)));
typedef float f32x4 __attribute__((ext_vector_type(4)));
typedef float f32x2v __attribute__((ext_vector_type(2)));
#define LDS_WAIT() asm volatile("s_waitcnt lgkmcnt(0)" ::: "memory")
#define VM_WAIT() asm volatile("s_waitcnt vmcnt(0)" ::: "memory")
__device__ __forceinline__ unsigned f2bf(float f) { unsigned u = __builtin_bit_cast(unsigned, f); return (u + 0x7fffu + ((u >> 16) & 1u)) >> 16; }
__device__ __forceinline__ unsigned pk2(float lo, float hi) { return f2bf(lo) | (f2bf(hi) << 16); }
__device__ __forceinline__ float bflo(unsigned u) { return __builtin_bit_cast(float, u << 16); }
__device__ __forceinline__ float bfhi(unsigned u) { return __builtin_bit_cast(float, u & 0xffff0000u); }
#define XB_TMO      128
#define XB_XCNT(j)  (256  + 64 * (j))
#define XB_XSUB(j)  (1280 + 64 * (j))
#define XB_XGEN(j)  (2304 + 64 * (j))
#define XB_TOP      3328
#define XB_TOPGEN   3392
#define XCD_BAR_WORDS 3456
#define XB_SPIN_CAP (1u << 18)

__device__ __forceinline__ unsigned xb_ld(unsigned* p)              { return __hip_atomic_load(p, __ATOMIC_RELAXED, __HIP_MEMORY_SCOPE_AGENT); }
__device__ __forceinline__ unsigned xb_add(unsigned* p, unsigned v) { return __hip_atomic_fetch_add(p, v, __ATOMIC_RELAXED, __HIP_MEMORY_SCOPE_AGENT); }
__device__ __forceinline__ unsigned xb_xcc_id() { return (unsigned)__builtin_amdgcn_s_getreg((3 << 11) | 20) & 0xFu; }
#define XB_SPIN(cond, bar) do { unsigned _sp = 0; while (cond) { __builtin_amdgcn_s_sleep(1); \
    if ((++_sp & 255u) == 0u) { if (xb_ld(&(bar)[XB_TMO])) break; if (_sp > XB_SPIN_CAP) { atomicAdd(&(bar)[XB_TMO], 1u); break; } } } } while (0)

struct XcdBarrier {
    unsigned* bar; unsigned x;
    volatile LAS unsigned* st;
};

__device__ __forceinline__ XcdBarrier xcd_barrier_post(unsigned* bar, volatile LAS unsigned* st) {
    XcdBarrier b; b.bar = bar; b.x = xb_xcc_id(); b.st = st;
    if (threadIdx.x == 0) (void)xb_add(&bar[XB_XCNT(b.x)], 1u);
    return b;
}
__device__ __forceinline__ void xcd_barrier_complete(unsigned* bar, unsigned x, unsigned& nloc, unsigned& nx) {
    const unsigned G = gridDim.x * gridDim.y * gridDim.z;
    unsigned sum, cnt, mine, sp = 0u;
    for (;;) {
        sum = 0u; cnt = 0u; mine = 0u;
#pragma unroll
        for (unsigned j = 0; j < 16; ++j) { const unsigned c = xb_ld(&bar[XB_XCNT(j)]); sum += c; cnt += (c > 0u) ? 1u : 0u; mine = (j == x) ? c : mine; }
        if (sum == G) break;
        __builtin_amdgcn_s_sleep(1);
        if ((++sp & 255u) == 0u) { if (xb_ld(&bar[XB_TMO])) break; if (sp > XB_SPIN_CAP) { atomicAdd(&bar[XB_TMO], 1u); break; } }
    }
    nloc = mine > 0u ? mine : 1u; nx = cnt > 0u ? cnt : 1u;
}

__device__ __forceinline__ void xcd_barrier(const XcdBarrier& b, const bool is_t0  ) {
    asm volatile("s_waitcnt vmcnt(0)" ::: "memory");
    __syncthreads();
    if (is_t0) {
        unsigned* bar = b.bar;
        __builtin_amdgcn_s_waitcnt(0);
        unsigned nloc = b.st[0], nx = b.st[1];
        if (nloc == 0u) { xcd_barrier_complete(bar, b.x, nloc, nx); b.st[0] = nloc; b.st[1] = nx; }
        const unsigned old = xb_add(&bar[XB_XSUB(b.x)], 1u);
        const unsigned gen = old / nloc;
        if (old + 1u == (gen + 1u) * nloc) {
            __builtin_amdgcn_fence(__ATOMIC_RELEASE, "agent");
            asm volatile("s_waitcnt vmcnt(0)" ::: "memory");
            const unsigned og = xb_add(&bar[XB_TOP], 1u);
            const unsigned tg = og / nx;
            if (og + 1u == (tg + 1u) * nx) xb_add(&bar[XB_TOPGEN], 1u);
            else XB_SPIN(xb_ld(&bar[XB_TOPGEN]) == tg, bar);
            __builtin_amdgcn_fence(__ATOMIC_ACQUIRE, "agent");
            xb_add(&bar[XB_XGEN(b.x)], 1u);
            asm volatile("s_waitcnt vmcnt(0)" ::: "memory");
        } else {
            XB_SPIN(xb_ld(&bar[XB_XGEN(b.x)]) == gen, bar);
            __builtin_amdgcn_fence(__ATOMIC_ACQUIRE, "agent");
            asm volatile("s_waitcnt vmcnt(0)" ::: "memory");
        }
    }
    __syncthreads();
}
struct U2 { unsigned lo, up; };
__device__ __forceinline__ U2 swap_self(unsigned v) {
    unsigned w = v; asm volatile("" : "+v"(w));
    auto rr = __builtin_amdgcn_permlane32_swap(v, w, false, false); U2 r; r.lo = rr[0]; r.up = rr[1]; return r;
}
__device__ __forceinline__ float swap_add(float v) { const U2 r = swap_self(__builtin_bit_cast(unsigned, v)); return __builtin_bit_cast(float, r.lo) + __builtin_bit_cast(float, r.up); }
__device__ __forceinline__ float swap_max(float v) { const U2 r = swap_self(__builtin_bit_cast(unsigned, v)); return fmaxf(__builtin_bit_cast(float, r.lo), __builtin_bit_cast(float, r.up)); }
template <int O> __device__ __forceinline__ unsigned xor_u(unsigned v) {
    if constexpr (O == 1) return (unsigned)__builtin_amdgcn_update_dpp(0, (int)v, 0xB1, 0xF, 0xF, true);
    else if constexpr (O == 2) return (unsigned)__builtin_amdgcn_update_dpp(0, (int)v, 0x4E, 0xF, 0xF, true);
    else return (unsigned)__builtin_amdgcn_ds_swizzle((int)v, (O << 10) | 0x1F);
}
template <int O> __device__ __forceinline__ float xor_f(float v) { return __builtin_bit_cast(float, xor_u<O>(__builtin_bit_cast(unsigned, v))); }
__device__ __forceinline__ float half_sum32(float v) {
    v += xor_f<1>(v); v += xor_f<2>(v); v += xor_f<4>(v); v += xor_f<8>(v); v += xor_f<16>(v); return v;
}
__device__ __forceinline__ float wave_sum(float v) {
    return swap_add(half_sum32(v));
}
__device__ __forceinline__ float wave_max(float v) {
    v = fmaxf(v, xor_f<1>(v)); v = fmaxf(v, xor_f<2>(v)); v = fmaxf(v, xor_f<4>(v)); v = fmaxf(v, xor_f<8>(v)); v = fmaxf(v, xor_f<16>(v));
    return swap_max(v);
}
__device__ __forceinline__ int wave_sum_i(int v) {
    v += (int)xor_u<1>((unsigned)v); v += (int)xor_u<2>((unsigned)v); v += (int)xor_u<4>((unsigned)v); v += (int)xor_u<8>((unsigned)v); v += (int)xor_u<16>((unsigned)v);
    const U2 r = swap_self((unsigned)v); return (int)(r.lo + r.up);
}
__device__ __forceinline__ float dot4(f32x4 a, f32x4 b) { return (a.x * b.x + a.y * b.y) + (a.z * b.z + a.w * b.w); }

struct Ctx { int tid, lane, wave, G, vcu, gw, NGW; LAS unsigned char* lds; };
__device__ __forceinline__ Ctx fresh(const Ctx& X) {
    Ctx Y = X; int l; asm volatile("v_mbcnt_lo_u32_b32 %0, -1, 0\n\tv_mbcnt_hi_u32_b32 %0, -1, %0" : "=v"(l));
    asm volatile("" : "+s"(Y.wave), "+s"(Y.vcu), "+s"(Y.G));
    Y.lane = l; Y.tid = Y.wave * 64 + l; Y.gw = Y.vcu * NWAVES + Y.wave; Y.NGW = Y.G * NWAVES; return Y;
}

enum { TR_ID = 0, TR_GLU = 1, TR_QKV = 2, TR_DSA = 3 };
__device__ __forceinline__ int tr_src(int r, int mode, int Nsrc) {
    if (mode == TR_ID) return r < Nsrc ? r : -1;
    if (mode == TR_GLU) return ((r >> 7) & 1) * 2048 + (r >> 8) * 128 + (r & 127);
    const int q = r & 127, wc = q >> 5, n = (q >> 4) & 1, f4 = q & 15;
    if (r < 4096 && mode == TR_DSA) return (r & ~255) + 128 * (wc >> 1) + 64 * ((r >> 7) & 1) + 32 * (wc & 1) + 2 * (f4 & 12) + 4 * n + (f4 & 3);
    if (r < 6144) return (r & ~127) + 32 * wc + 2 * (f4 & 12) + 4 * n + (f4 & 3);
    if (mode == TR_QKV) return -1;
    if (r < 7168) return (r & ~255) + 64 * wc + 32 * ((r >> 7) & 1) + 2 * (f4 & 12) + 4 * n + (f4 & 3);
    if (r < 7168 + 128) { if (wc < 2) return 7168 + 16 * wc + f4 + 32 * n; if (wc == 2 && n == 0) return 7232 + f4; }
    return -1;
}
__device__ __forceinline__ void tr_item(const float* W, int K, int Nsrc, bf16* WT, int mode, int item, int nblk, int lane, LAS unsigned char* stg) {
    const int kb = item / nblk, nb = item - kb * nblk, k0 = 64 * kb, r0 = 128 * nb + 2 * lane, sc4 = tr_src(r0 & ~3, mode, Nsrc), sc = sc4 < 0 ? -1 : sc4 + (r0 & 3);
    f32x2v v[64];
    if (sc >= 0) { const float* src = W + (size_t)k0 * Nsrc + sc;
#pragma unroll
        for (int i = 0; i < 64; ++i) v[i] = *(const f32x2v*)(src + (size_t)i * Nsrc); }
    else {
#pragma unroll
        for (int i = 0; i < 64; ++i) v[i] = (f32x2v){0.f, 0.f}; }
#pragma unroll
    for (int j = 0; j < 2; ++j) {
#pragma unroll
        for (int q = 0; q < 8; ++q) { v4u o; o.x = pg8::cvt_pk_bf16(v[8 * q][j], v[8 * q + 1][j]); o.y = pg8::cvt_pk_bf16(v[8 * q + 2][j], v[8 * q + 3][j]); o.z = pg8::cvt_pk_bf16(v[8 * q + 4][j], v[8 * q + 5][j]); o.w = pg8::cvt_pk_bf16(v[8 * q + 6][j], v[8 * q + 7][j]);
            const int slot = ((((q ^ (lane & 7)) << 1) | j) ^ ((lane >> 3) & 1));
            *(LAS v4u*)(stg + lane * 256 + slot * 16) = o; } }
    LDS_WAIT();
    bf16* dst = WT + (size_t)(128 * nb + (lane >> 3)) * K + k0 + 8 * (lane & 7);
#pragma unroll
    for (int s2 = 0; s2 < 16; ++s2) { const int n = 8 * s2 + (lane >> 3), pp = n >> 1, q = lane & 7;
        const int slot = ((((q ^ (pp & 7)) << 1) | (n & 1)) ^ ((pp >> 3) & 1));
        const v4u o = *(LAS v4u*)(stg + pp * 256 + slot * 16);
        *(v4u*)(dst + (size_t)(8 * s2) * K) = o; }
    LDS_WAIT();
}
__device__ __forceinline__ void tr_matrix(const Ctx& X, const float* W, int K, int Nsrc, int Ndst, bf16* WT, int mode, int& rot, int gw, int ngw) {
    const int nblk = Ndst / 128, nitems = (K / 64) * nblk;
    int first = gw - rot; if (first < 0) first += ngw;
    for (int it = first; it < nitems; it += ngw) tr_item(W, K, Nsrc, WT, mode, it, nblk, X.lane, X.lds + RING_OFF + X.wave * 16384);
    rot = (rot + nitems) % ngw;
}
__device__ __forceinline__ void ph_rope_tables(const Ctx& X, const int* positions, float* CS, float* CS2) {
    for (int idx = X.gw * 64 + X.lane; idx < M * 96; idx += X.NGW * 64) {
        const int m = idx / 96, i = idx - m * 96; const float pos = (float)positions[m];
        if (i < 64) { const float a = pos * exp2f(-(float)i * (13.287712379549449f / 64.0f)); CS[(size_t)m * 128 + i] = cosf(a); CS[(size_t)m * 128 + 64 + i] = sinf(a); }
        else { const int i2 = i - 64; const float a = pos * exp2f(-(float)i2 * (13.287712379549449f / 32.0f)); CS2[(size_t)m * 64 + i2] = cosf(a); CS2[(size_t)m * 64 + 32 + i2] = sinf(a); }
    }
}
__device__ __forceinline__ void ph_mod(const Ctx& X, const float* cin, const float* ada_w, const float* ada_b, float* MOD) {
    LAS float* condl = (LAS float*)(X.lds + RING_OFF);
    LAS float* red = (LAS float*)(X.lds + RING_OFF + 32768);
    for (int i = X.tid; i < NB * D; i += 512) { const float c = cin[i]; condl[i] = c / (1.0f + __expf(-c)); }
    __syncthreads();
    for (int it = (int)((blockIdx.x + X.G - 64 % X.G) % X.G); it < NL * 48; it += X.G) {
        const int l = it / 48, n0 = (it % 48) * 256;
        const float* W = ada_w + (size_t)l * D * (6 * D) + n0 + 4 * X.lane;
        f32x4 a0 = {0.f, 0.f, 0.f, 0.f}, a1 = a0, a2 = a0, a3 = a0;
#pragma unroll 8
        for (int kk = 0; kk < 256; ++kk) { const int k = X.wave * 256 + kk; const f32x4 w = *(const f32x4*)(W + (size_t)k * (6 * D));
            a0 += condl[k] * w; a1 += condl[2048 + k] * w; a2 += condl[4096 + k] * w; a3 += condl[6144 + k] * w; }
        *(LAS f32x4*)(red + (X.wave * 4 + 0) * 256 + 4 * X.lane) = a0; *(LAS f32x4*)(red + (X.wave * 4 + 1) * 256 + 4 * X.lane) = a1;
        *(LAS f32x4*)(red + (X.wave * 4 + 2) * 256 + 4 * X.lane) = a2; *(LAS f32x4*)(red + (X.wave * 4 + 3) * 256 + 4 * X.lane) = a3;
        __syncthreads();
        for (int o = X.tid; o < 1024; o += 512) { const int b = o >> 8, c = o & 255; float s = 0.f;
#pragma unroll
            for (int w = 0; w < 8; ++w) s += red[(w * 4 + b) * 256 + c];
            MOD[(size_t)(l * NB + b) * (6 * D) + n0 + c] = s + ada_b[(size_t)l * (6 * D) + n0 + c]; }
        __syncthreads();
    }
}
__device__ __forceinline__ void ph_ln_mod(const Ctx& X, const float* x, const float* lng, const float* modl, int sh_off, int sc_off, bf16* H) {
    const int lane = X.lane;
    const int nbw = X.NGW / NB, b = X.gw / nbw, gwb = X.gw - b * nbw;
    if (b < NB) {
        const float* mb = modl + (size_t)b * (6 * D);
        f32x4 ga[8], sh[8];
#pragma unroll
        for (int j = 0; j < 8; ++j) { const int col = 4 * lane + 256 * j; ga[j] = *(const f32x4*)(lng + col) * (1.0f + *(const f32x4*)(mb + sc_off + col)); sh[j] = *(const f32x4*)(mb + sh_off + col); }
        f32x4 vq[3][8];
#pragma unroll
        for (int q = 0; q < 2; ++q) { if (gwb + q * nbw < S) { const f32x4* xr = (const f32x4*)(x + ((size_t)b * S + gwb + q * nbw) * D) + lane;
#pragma unroll
            for (int j = 0; j < 8; ++j) vq[q][j] = xr[64 * j]; } }
        for (int t3 = gwb; t3 < S; t3 += 3 * nbw) {
#pragma unroll
            for (int q = 0; q < 3; ++q) { const int t = t3 + q * nbw;
                if (t < S) {
                    if (t + 2 * nbw < S) { const f32x4* xr = (const f32x4*)(x + ((size_t)b * S + t + 2 * nbw) * D) + lane;
#pragma unroll
                        for (int j = 0; j < 8; ++j) vq[(q + 2) % 3][j] = xr[64 * j]; }
                    float ss = 0.f;
#pragma unroll
                    for (int j = 0; j < 8; ++j) ss += dot4(vq[q][j], vq[q][j]);
                    ss = wave_sum(ss);
                    const float r = 1.0f / sqrtf(ss * (1.0f / D) + EPS);
                    bf16* hrow = H + ((size_t)b * S + t) * D + 4 * lane;
#pragma unroll
                    for (int j = 0; j < 8; ++j) { const f32x4 y = vq[q][j] * r * ga[j] + sh[j];
                        v2u o; o.x = pg8::cvt_pk_bf16(y.x, y.y); o.y = pg8::cvt_pk_bf16(y.z, y.w);
                        *(v2u*)(hrow + 256 * j) = o; }
                }
            }
        }
    }
}
typedef _Float16 h16x8 __attribute__((ext_vector_type(8)));
__device__ __forceinline__ void ph_ln_mod_h(const Ctx& X, const _Float16* x, const float* lng, const float* modl, int sh_off, int sc_off, bf16* H) {
    const int lane = X.lane;
    const int nbw = X.NGW / NB, b = X.gw / nbw, gwb = X.gw - b * nbw;
    if (b < NB) {
        const float* mb = modl + (size_t)b * (6 * D);
        f32x4 ga[8], sh[8];
#pragma unroll
        for (int j = 0; j < 8; ++j) { const int col = 8 * lane + 512 * (j >> 1) + 4 * (j & 1); ga[j] = *(const f32x4*)(lng + col) * (1.0f + *(const f32x4*)(mb + sc_off + col)); sh[j] = *(const f32x4*)(mb + sh_off + col); }
        h16x8 vq[LN_AHEAD + 1][4];
#pragma unroll
        for (int q = 0; q < LN_AHEAD; ++q) { if (gwb + q * nbw < S) { const h16x8* xr = (const h16x8*)(x + ((size_t)b * S + gwb + q * nbw) * D) + lane;
#pragma unroll
            for (int j = 0; j < 4; ++j) vq[q][j] = xr[64 * j]; } }
        for (int t4 = gwb; t4 < S; t4 += (LN_AHEAD + 1) * nbw) {
#pragma unroll
            for (int q = 0; q < LN_AHEAD + 1; ++q) { const int t = t4 + q * nbw;
                if (t < S) {
                    if (t + LN_AHEAD * nbw < S) { const h16x8* xr = (const h16x8*)(x + ((size_t)b * S + t + LN_AHEAD * nbw) * D) + lane;
#pragma unroll
                        for (int j = 0; j < 4; ++j) vq[(q + LN_AHEAD) % (LN_AHEAD + 1)][j] = xr[64 * j]; }
                    f32x4 v[8];
#pragma unroll
                    for (int j = 0; j < 4; ++j) { const h16x8 hv = vq[q][j]; v[2 * j] = (f32x4){(float)hv[0], (float)hv[1], (float)hv[2], (float)hv[3]}; v[2 * j + 1] = (f32x4){(float)hv[4], (float)hv[5], (float)hv[6], (float)hv[7]}; }
                    float ss = 0.f;
#pragma unroll
                    for (int j = 0; j < 8; ++j) ss += dot4(v[j], v[j]);
                    ss = wave_sum(ss);
                    const float r = 1.0f / sqrtf(ss * (1.0f / D) + EPS);
                    bf16* hrow = H + ((size_t)b * S + t) * D + 8 * lane;
#pragma unroll
                    for (int j = 0; j < 4; ++j) { const f32x4 y0 = v[2 * j] * r * ga[2 * j] + sh[2 * j], y1 = v[2 * j + 1] * r * ga[2 * j + 1] + sh[2 * j + 1];
                        v4u o; o.x = pg8::cvt_pk_bf16(y0.x, y0.y); o.y = pg8::cvt_pk_bf16(y0.z, y0.w); o.z = pg8::cvt_pk_bf16(y1.x, y1.y); o.w = pg8::cvt_pk_bf16(y1.z, y1.w);
                        *(v4u*)(hrow + 512 * j) = o; }
                }
            }
        }
    }
}
#define SEL_WRLANE(w, v, LN) asm("s_nop 1\n\tv_writelane_b32 %0, %1, %2" : "+v"(w) : "s"(v), "i"(LN))
template <int NG8>
__device__ __forceinline__ void sel_row(int lane, int t, __amdgpu_buffer_rsrc_t rS, unsigned row_off, unsigned* bw) {
    constexpr int NR = 8 * NG8, J0 = NR - 8;
    unsigned key[NR];
    const unsigned lane4 = (unsigned)lane * 4u;
#pragma unroll
    for (int j = 0; j < J0; ++j) key[j] = __builtin_amdgcn_raw_buffer_load_b32(rS, lane4, row_off + 256u * j, 0);
#pragma unroll
    for (int j = J0; j < NR; ++j) { const int d4 = 4 * (t - 64 * j); int v4 = (int)lane4 < d4 ? (int)lane4 : d4; v4 = v4 > 0 ? v4 : 0;
        key[j] = __builtin_amdgcn_raw_buffer_load_b32(rS, (unsigned)v4, row_off + 256u * j, 0); }
    asm volatile("" ::: "memory");
#pragma unroll
    for (int j = 0; j < NR; ++j) { const unsigned u = key[j]; const unsigned img = u ^ ((unsigned)((int)u >> 31) | 0x80000000u);
        key[j] = (j < J0 || lane <= t - 64 * j) ? img : 0u; }
    unsigned T = 0u; bool exact = false;
#pragma unroll 1
    for (int bit = 31; bit >= 0; --bit) { const unsigned cand = T | (1u << bit); int cnt = 0;
#pragma unroll
        for (int g8 = 0; g8 < NG8; ++g8) { unsigned long long m0, m1, m2, m3, m4, m5, m6, m7;
            asm volatile("v_cmp_ge_u32_e64 %0, %8, %16\n\tv_cmp_ge_u32_e64 %1, %9, %16\n\tv_cmp_ge_u32_e64 %2, %10, %16\n\tv_cmp_ge_u32_e64 %3, %11, %16\n\t"
                         "v_cmp_ge_u32_e64 %4, %12, %16\n\tv_cmp_ge_u32_e64 %5, %13, %16\n\tv_cmp_ge_u32_e64 %6, %14, %16\n\tv_cmp_ge_u32_e64 %7, %15, %16"
                         : "=s"(m0), "=s"(m1), "=s"(m2), "=s"(m3), "=s"(m4), "=s"(m5), "=s"(m6), "=s"(m7)
                         : "v"(key[g8 * 8]), "v"(key[g8 * 8 + 1]), "v"(key[g8 * 8 + 2]), "v"(key[g8 * 8 + 3]), "v"(key[g8 * 8 + 4]), "v"(key[g8 * 8 + 5]), "v"(key[g8 * 8 + 6]), "v"(key[g8 * 8 + 7]), "v"(cand));
            cnt += (__popcll(m0) + __popcll(m1)) + (__popcll(m2) + __popcll(m3)) + (__popcll(m4) + __popcll(m5)) + (__popcll(m6) + __popcll(m7)); }
        if (cnt >= TOPK) T = cand;
        if (cnt == TOPK) { exact = true; break; } }
    unsigned w0 = 0u, w1 = 0u;
    if (exact) {
#pragma unroll
        for (int j = 0; j < NR; ++j) { const unsigned long long ms = __ballot(key[j] >= T);
            { const unsigned mlo = (unsigned)ms, mhi = (unsigned)(ms >> 32);
            if (j < 32) { SEL_WRLANE(w0, mlo, (2 * j) & 63); SEL_WRLANE(w0, mhi, (2 * j + 1) & 63); }
            else { SEL_WRLANE(w1, mlo, (2 * j) & 63); SEL_WRLANE(w1, mhi, (2 * j + 1) & 63); } } }
    } else {
        int cgt = 0;
#pragma unroll
        for (int j = 0; j < NR; ++j) cgt += __popcll(__ballot(key[j] > T));
        const int need = TOPK - cgt; int run = 0;
#pragma unroll
        for (int j = 0; j < NR; ++j) { const bool gt = key[j] > T, eq = key[j] == T;
            const unsigned long long meq = __ballot(eq);
            const int rank = run + (int)__builtin_amdgcn_mbcnt_hi((unsigned)(meq >> 32), __builtin_amdgcn_mbcnt_lo((unsigned)meq, 0u));
            const bool sel = gt || (eq && rank < need); run += __popcll(meq);
            const unsigned long long ms = __ballot(sel);
            { const unsigned mlo = (unsigned)ms, mhi = (unsigned)(ms >> 32);
            if (j < 32) { SEL_WRLANE(w0, mlo, (2 * j) & 63); SEL_WRLANE(w0, mhi, (2 * j + 1) & 63); }
            else { SEL_WRLANE(w1, mlo, (2 * j) & 63); SEL_WRLANE(w1, mhi, (2 * j + 1) & 63); } } }
    }
    bw[lane] = w0; bw[64 + lane] = w1;
}
__device__ __forceinline__ void ph_idx_scores(const Ctx& X, const bf16* QI, const bf16* KI, const float* WI, float* SC, unsigned* BITS) {
    typedef short bf16x8 __attribute__((ext_vector_type(8)));
    typedef float f32x16 __attribute__((ext_vector_type(16)));
    const int tid = X.tid, lane = X.lane, wid = X.wave, r32 = lane & 31, hi = lane >> 5;
    LAS char* lds = (LAS char*)(X.lds + RING_OFF);
    const __amdgpu_buffer_rsrc_t rK = __builtin_amdgcn_make_buffer_rsrc((void*)KI, (short)0, M * 64 * 2, 0x00020000);
    const __amdgpu_buffer_rsrc_t rQ = __builtin_amdgcn_make_buffer_rsrc((void*)QI, (short)0, M * 1024 * 2, 0x00020000);
    const __amdgpu_buffer_rsrc_t rS = __builtin_amdgcn_make_buffer_rsrc((void*)SC, (short)0, 0x40000000, 0x00020000);
    unsigned st_g[4], st_l[4];
#pragma unroll
    for (int j = 0; j < 4; ++j) { const int p = tid + 512 * j, key = p >> 3, pc = p & 7; st_g[j] = (unsigned)p * 16u; st_l[j] = (unsigned)(key * 128 + ((pc ^ ((key >> 1) & 7)) << 4)); }
    unsigned rd[4];
#pragma unroll
    for (int d0 = 0; d0 < 4; ++d0) rd[d0] = (unsigned)(r32 * 128 + (((2 * d0 + hi) ^ ((r32 >> 1) & 7)) << 4));
    const int qsel = (r32 >> 2) & 1, hsel = (r32 & 3) + 4 * (r32 >> 3);
    for (int slot = X.vcu; slot < 256; slot += X.G) {
        for (int b = 0; b < NB; ++b) {
            const int blk = (b & 1) ? 255 - slot : slot;
            const int t0 = blk * 16, m0 = b * S + t0, tq = t0 + 2 * wid;
            const int nch = (t0 + 15) / 256 + 1;
            bf16x8 afr[4];
#pragma unroll
            for (int d0 = 0; d0 < 4; ++d0) afr[d0] = __builtin_bit_cast(bf16x8, __builtin_amdgcn_raw_buffer_load_b128(rQ, (unsigned)((2 * wid + qsel) * 1024 + hsel * 64 + d0 * 16 + hi * 8) * 2u, (unsigned)m0 * 2048u, 0));
            float wv[16];
#pragma unroll
            for (int q = 0; q < 4; ++q) { const f32x4 w4 = *(const f32x4*)(WI + (size_t)(m0 + 2 * wid + hi) * 16 + 4 * q);
                wv[4 * q] = w4.x; wv[4 * q + 1] = w4.y; wv[4 * q + 2] = w4.z; wv[4 * q + 3] = w4.w; }
            v4u st[4];
            __syncthreads();
#pragma unroll
            for (int j = 0; j < 4; ++j) st[j] = __builtin_amdgcn_raw_buffer_load_b128(rK, st_g[j], (unsigned)(b * S) * 128u, 0);
#pragma unroll
            for (int j = 0; j < 4; ++j) *(LAS v4u*)(lds + st_l[j]) = st[j];
            __syncthreads();
            for (int c = 0; c < nch; ++c) {
                const int kb = c * 256, buf = c & 1; const bool more = c + 1 < nch;
                if (more) {
#pragma unroll
                    for (int j = 0; j < 4; ++j) st[j] = __builtin_amdgcn_raw_buffer_load_b128(rK, st_g[j], (unsigned)(b * S + kb + 256) * 128u, 0); }
                const LAS char* cb = lds + buf * 32768;
                const unsigned srow = (unsigned)(m0 + 2 * wid) * (unsigned)(S * 4) + (unsigned)kb * 4u;
                const int ngrp = ((tq + 1 - kb) >> 5) + 1;
#define IDX_LOADB(GP, B0, B1) _Pragma("unroll") for (int d0 = 0; d0 < 4; ++d0) { B0[d0] = *(const LAS bf16x8*)(cb + (2 * (GP)) * 4096 + rd[d0]); B1[d0] = *(const LAS bf16x8*)(cb + (2 * (GP) + 1) * 4096 + rd[d0]); }
#define IDX_MMA(B0, B1, A0, A1) _Pragma("unroll") for (int d0 = 0; d0 < 4; ++d0) { A0 = __builtin_amdgcn_mfma_f32_32x32x16_bf16(afr[d0], B0[d0], A0, 0, 0, 0); A1 = __builtin_amdgcn_mfma_f32_32x32x16_bf16(afr[d0], B1[d0], A1, 0, 0, 0); }
#define IDX_FIN(ACC, GRP) do { typedef int i32x16 __attribute__((ext_vector_type(16))); \
                    const f32x16 rl_ = __builtin_bit_cast(f32x16, __builtin_elementwise_max(__builtin_bit_cast(i32x16, ACC), (i32x16)(0)));     \
                    float s0_ = 0.f, s1_ = 0.f; _Pragma("unroll") for (int r = 0; r < 16; r += 2) { s0_ = __builtin_fmaf(wv[r], rl_[r], s0_); s1_ = __builtin_fmaf(wv[r + 1], rl_[r + 1], s1_); } \
                    __builtin_amdgcn_raw_buffer_store_b32(__builtin_bit_cast(unsigned, s0_ + s1_), rS, (unsigned)(hi * (S * 4) + ((GRP) * 32 + r32) * 4), srow, 0); } while (0)
                if (ngrp >= 8) {
                    bf16x8 bA[4], bB[4]; f32x16 pa0 = {}, pa1 = {};
                    IDX_LOADB(0, bA, bB); IDX_MMA(bA, bB, pa0, pa1);
#pragma unroll
                    for (int gp = 0; gp < 4; ++gp) {
                        f32x16 na0 = {}, na1 = {};
                        if (gp < 3) { IDX_LOADB(gp + 1, bA, bB); IDX_MMA(bA, bB, na0, na1); }
                        IDX_FIN(pa0, 2 * gp); IDX_FIN(pa1, 2 * gp + 1);
                        pa0 = na0; pa1 = na1;
                    }
                } else {
#pragma unroll
                    for (int gp = 0; gp < 4; ++gp) {
                        if (2 * gp < ngrp) {
                            bf16x8 bA[4], bB[4]; f32x16 pa0 = {}, pa1 = {};
                            IDX_LOADB(gp, bA, bB); IDX_MMA(bA, bB, pa0, pa1);
                            IDX_FIN(pa0, 2 * gp); IDX_FIN(pa1, 2 * gp + 1);
                        }
                    }
                }
#undef IDX_LOADB
#undef IDX_MMA
#undef IDX_FIN
                if (more) {
#pragma unroll
                    for (int j = 0; j < 4; ++j) *(LAS v4u*)(lds + (buf ^ 1) * 32768 + st_l[j]) = st[j]; }
                __syncthreads();
            }
            asm volatile("s_waitcnt vmcnt(0)" ::: "memory");
#pragma unroll 1
            for (int r = 0; r < 2; ++r) {
                const int t = tq + r, m = m0 + 2 * wid + r;
                unsigned* bw = BITS + (size_t)m * 128;
                if (t < TOPK) {
#pragma unroll
                    for (int q = 0; q < 2; ++q) { const int w = lane + 64 * q, lo = 32 * w; bw[w] = (t >= lo + 31) ? 0xffffffffu : (t < lo ? 0u : ((2u << (t - lo)) - 1u)); }
                    continue;
                }
                const unsigned row_off = (unsigned)m * (unsigned)(S * 4);
                switch (t >> 9) {
                    case 0: sel_row<1>(lane, t, rS, row_off, bw); break;
                    case 1: sel_row<2>(lane, t, rS, row_off, bw); break;
                    case 2: sel_row<3>(lane, t, rS, row_off, bw); break;
                    case 3: sel_row<4>(lane, t, rS, row_off, bw); break;
                    case 4: sel_row<5>(lane, t, rS, row_off, bw); break;
                    case 5: sel_row<6>(lane, t, rS, row_off, bw); break;
                    case 6: sel_row<7>(lane, t, rS, row_off, bw); break;
                    default: sel_row<8>(lane, t, rS, row_off, bw); break;
                }
            }
        }
    }
}
__device__ __forceinline__ void ph_s5_pre(const Ctx& X, const float* lre, const float* lim, const float* logdt, const float* bre, const float* bim, const float* cre, const float* cim,
                                          float* S5C, bf16* B1, bf16* B3) {
    LAS float* APr = (LAS float*)(X.lds + RING_OFF);
    LAS float* APi = APr + 17 * 64;
    LAS float* BBr = APi + 17 * 64;
    LAS float* BBi = BBr + 1024;
    LAS float* CR = BBi + 1024;
    LAS float* CI = CR + 1024;
    LAS float* KT = CI + 1024;
    float* AT16R = S5C; float* AT16I = S5C + G5 * P5;
    for (int w2 = blockIdx.x; 2 * w2 < G5; w2 += X.G) for (int e2 = 0; e2 < 2; ++e2) {
        const int g = 2 * w2 + e2;
        __syncthreads();
        if (X.tid < 64) { const int p = X.tid, gp = g * 64 + p;
            const float dt = expf(logdt[g]), lr = lre[gp], li = lim[gp];
            const float mag = expf(lr * dt), ang = li * dt, ar = mag * cosf(ang), ai = mag * sinf(ang);
            const float den = lr * lr + li * li;
            const float fr = ((ar - 1.0f) * lr + ai * li) / den, fi = (ai * lr - (ar - 1.0f) * li) / den;
            float pr = 1.0f, pi = 0.0f;
            for (int tau = 0; tau <= 16; ++tau) { APr[tau * 64 + p] = pr; APi[tau * 64 + p] = pi; const float nr = pr * ar - pi * ai, ni = pr * ai + pi * ar; pr = nr; pi = ni; }
            AT16R[gp] = APr[16 * 64 + p]; AT16I[gp] = APi[16 * 64 + p];
            for (int c = 0; c < C5; ++c) { const float br = bre[(size_t)gp * C5 + c], bi = bim[(size_t)gp * C5 + c]; BBr[p * 16 + c] = fr * br - fi * bi; BBi[p * 16 + c] = fr * bi + fi * br; } }
        for (int i = X.tid; i < 1024; i += 512) { CR[i] = cre[(size_t)g * 1024 + i]; CI[i] = cim[(size_t)g * 1024 + i]; }
        __syncthreads();
        for (int o = X.tid; o < 4096; o += 512) { const int tau = o >> 8, c = (o >> 4) & 15, cp = o & 15; float sacc = 0.f;
            for (int p = 0; p < 64; ++p) { const float ar_ = APr[tau * 64 + p], ai_ = APi[tau * 64 + p], br_ = BBr[p * 16 + cp], bi_ = BBi[p * 16 + cp];
                sacc += CR[c * 64 + p] * (ar_ * br_ - ai_ * bi_) - CI[c * 64 + p] * (ar_ * bi_ + ai_ * br_); }
            KT[o] = sacc; }
        __syncthreads();
        bf16* b3 = B3 + (size_t)g * 256 * 384;
        for (int idx = X.tid; idx < 256 * 192; idx += 512) { const int n = idx / 192, kp = idx - n * 192, t = n >> 4, c = n & 15; float v[2];
#pragma unroll
            for (int e = 0; e < 2; ++e) { const int k = 2 * kp + e;
                if (k < 256) { const int sx = k >> 4, cp = k & 15; v[e] = (sx <= t) ? KT[((t - sx) << 8) + (c << 4) + cp] : 0.f; }
                else if (k < 320) { const int p = k - 256; v[e] = CR[c * 64 + p] * APr[(t + 1) * 64 + p] - CI[c * 64 + p] * APi[(t + 1) * 64 + p]; }
                else { const int p = k - 320; v[e] = -(CR[c * 64 + p] * APi[(t + 1) * 64 + p] + CI[c * 64 + p] * APr[(t + 1) * 64 + p]); } }
            *(unsigned*)(b3 + (size_t)n * 384 + 2 * kp) = pk2(v[0], v[1]); }
        bf16* b1 = B1 + (size_t)g * 256 * 256;
        for (int idx = X.tid; idx < 256 * 128; idx += 512) { const int n = idx >> 7, kp = idx & 127; float v[2] = {0.f, 0.f};
            if (n < 128) { const int ri = n >> 6, p = n & 63;
#pragma unroll
                for (int e = 0; e < 2; ++e) { const int k = 2 * kp + e, sx = k >> 4, cp = k & 15; const float ar_ = APr[(15 - sx) * 64 + p], ai_ = APi[(15 - sx) * 64 + p], br_ = BBr[p * 16 + cp], bi_ = BBi[p * 16 + cp];
                    v[e] = ri ? (ar_ * bi_ + ai_ * br_) : (ar_ * br_ - ai_ * bi_); } }
            *(unsigned*)(b1 + (size_t)n * 256 + 2 * kp) = pk2(v[0], v[1]); }
    }
    __syncthreads();
}
__device__ __forceinline__ void ph_s5_carry(const Ctx& X, const float* S5C, const float* E, bf16* AG) {
    const float* AT16R = S5C; const float* AT16I = S5C + G5 * P5;
    const int lane = X.lane;
    for (int it = X.gw; it < G5 * NB; it += X.NGW) {
        const int g = it >> 2, b = it & 3; const float ar = AT16R[g * 64 + lane], ai = AT16I[g * 64 + lane];
        const float* er = E + (size_t)(g * 1024 + b * 256) * 128 + lane; bf16* hrow = AG + (size_t)(g * 1024 + b * 256) * 384 + 256 + lane;
        float hr = 0.f, hi = 0.f;
        for (int k0 = 0; k0 < 256; k0 += 64) { float e0[64], e1[64];
#pragma unroll
            for (int q = 0; q < 64; ++q) { e0[q] = er[(size_t)(k0 + q) * 128]; e1[q] = er[(size_t)(k0 + q) * 128 + 64]; }
#pragma unroll
            for (int q = 0; q < 64; ++q) { hrow[(size_t)(k0 + q) * 384] = (bf16)f2bf(hr); hrow[(size_t)(k0 + q) * 384 + 64] = (bf16)f2bf(hi);
                const float nr = ar * hr - ai * hi + e0[q], ni = ar * hi + ai * hr + e1[q]; hr = nr; hi = ni; } }
    }
}
namespace att {
typedef short bf16x8 __attribute__((ext_vector_type(8)));
typedef short s16x4 __attribute__((ext_vector_type(4)));
typedef float f32x16 __attribute__((ext_vector_type(16)));
constexpr int KVBLK = 64, SHM_K = KVBLK * HD * 2, SHM_V = SHM_K;
constexpr int OFF_V = 0, OFF_K = 2 * SHM_V, OFF_WS = 2 * SHM_V + 2 * SHM_K, OFF_FLAG = OFF_WS + NWAVES * 256;
#define KSWZ(row, colB) ((row) * 256 + ((colB) ^ (((row) & 7) << 4)))
__device__ __forceinline__ int v_st(int k, int c) { const int kk = (k & ~0xC) | ((k & 4) << 1) | ((k & 8) >> 1); return ((kk >> 3) * 4 + (c >> 5)) * 512 + ((kk & 7) * 32 + (c & 31)) * 2; }
__device__ __forceinline__ int v_rd_base(int lane) { return ((lane & 3) << 3) | (((lane >> 2) & 3) << 6) | (((lane >> 4) & 1) << 5) | (((lane >> 5) & 1) << 8); }
constexpr int v_rd_off(int d0, int ks, int half) { return d0 * 512 + ks * 4096 + half * 2048; }
__device__ __forceinline__ int crow(int r, int hi) { return (r & 3) + 8 * (r >> 2) + 4 * hi; }
__device__ __forceinline__ unsigned cvtpk(float lo, float hi) { unsigned r; asm volatile("v_cvt_pk_bf16_f32 %0, %1, %2" : "=v"(r) : "v"(lo), "v"(hi)); return r; }
#define ATT_PK4(P, B_, OUT) do { unsigned a0 = cvtpk(P[B_+0], P[B_+1]), a1 = cvtpk(P[B_+2], P[B_+3]);                          \
        unsigned b0 = cvtpk(P[B_+4], P[B_+5]), b1 = cvtpk(P[B_+6], P[B_+7]);                                             \
        auto r0 = __builtin_amdgcn_permlane32_swap(a0, b0, false, false); auto r1 = __builtin_amdgcn_permlane32_swap(a1, b1, false, false); \
        v4u w = {r0[0], r1[0], r0[1], r1[1]}; OUT = *reinterpret_cast<bf16x8*>(&w); } while (0)

__device__ __forceinline__ void qkt(f32x16& p0, f32x16& p1, const LAS char* Kt, int r32, int hi, const bf16x8* qr) {
    p0 = f32x16{}; p1 = f32x16{};
    const LAS char* kb[4];
#pragma unroll
    for (int dd = 0; dd < 4; ++dd) kb[dd] = Kt + KSWZ(r32, (dd * 16 + hi * 8) * 2);
#pragma unroll
    for (int d0 = 0; d0 < 8; ++d0) { const LAS char* a = kb[d0 & 3] + (d0 >> 2) * 128;
        const bf16x8 b0 = *reinterpret_cast<const LAS bf16x8*>(a);
        const bf16x8 b1 = *reinterpret_cast<const LAS bf16x8*>(a + 32 * 256);
        p0 = __builtin_amdgcn_mfma_f32_32x32x16_bf16(b0, qr[d0], p0, 0, 0, 0);
        p1 = __builtin_amdgcn_mfma_f32_32x32x16_bf16(b1, qr[d0], p1, 0, 0, 0); }
}
__device__ __forceinline__ void pv_tile(f32x16* o, int vb0, bf16x8 pa0, bf16x8 pa1, bf16x8 pa2, bf16x8 pa3) {
#define ATT_TRRD(dst, off) asm volatile("ds_read_b64_tr_b16 %0, %1 offset:%2" : "=&v"(dst) : "v"(vb0), "i"(off) : "memory")
#define ATT_PV_D0(d0) do { s16x4 l0, l1, l2, l3, h0, h1, h2, h3; constexpr int b_ = v_rd_off(d0, 0, 0); \
        ATT_TRRD(l0, b_); ATT_TRRD(h0, b_ + 2048); ATT_TRRD(l1, b_ + 4096); ATT_TRRD(h1, b_ + 6144); ATT_TRRD(l2, b_ + 8192); ATT_TRRD(h2, b_ + 10240); ATT_TRRD(l3, b_ + 12288); ATT_TRRD(h3, b_ + 14336); \
        asm volatile("s_waitcnt lgkmcnt(0)" ::: "memory"); __builtin_amdgcn_sched_barrier(0);   \
        o[d0] = __builtin_amdgcn_mfma_f32_32x32x16_bf16((bf16x8){l0[0], l0[1], l0[2], l0[3], h0[0], h0[1], h0[2], h0[3]}, pa0, o[d0], 0, 0, 0);   \
        o[d0] = __builtin_amdgcn_mfma_f32_32x32x16_bf16((bf16x8){l1[0], l1[1], l1[2], l1[3], h1[0], h1[1], h1[2], h1[3]}, pa1, o[d0], 0, 0, 0);   \
        o[d0] = __builtin_amdgcn_mfma_f32_32x32x16_bf16((bf16x8){l2[0], l2[1], l2[2], l2[3], h2[0], h2[1], h2[2], h2[3]}, pa2, o[d0], 0, 0, 0);   \
        o[d0] = __builtin_amdgcn_mfma_f32_32x32x16_bf16((bf16x8){l3[0], l3[1], l3[2], l3[3], h3[0], h3[1], h3[2], h3[3]}, pa3, o[d0], 0, 0, 0); } while (0)
    ATT_PV_D0(0); ATT_PV_D0(1); ATT_PV_D0(2); ATT_PV_D0(3);
#undef ATT_PV_D0
#undef ATT_TRRD
}
__device__ __forceinline__ void store_o_rows(const f32x16* o, float scale, __amdgpu_buffer_rsrc_t rO, unsigned rowoff, unsigned soff) {
#pragma unroll
    for (int d0 = 0; d0 < 4; ++d0) {
        unsigned gx[4], gy[4];
#pragma unroll
        for (int g = 0; g < 4; ++g) { gx[g] = cvtpk(o[d0][4 * g] * scale, o[d0][4 * g + 1] * scale); gy[g] = cvtpk(o[d0][4 * g + 2] * scale, o[d0][4 * g + 3] * scale); }
#pragma unroll
        for (int k = 0; k < 4; k += 2) {
            auto rx = __builtin_amdgcn_permlane32_swap(gx[k], gx[k + 1], false, false); auto ry = __builtin_amdgcn_permlane32_swap(gy[k], gy[k + 1], false, false);
            const v4u w = {rx[0], ry[0], rx[1], ry[1]};
            __builtin_amdgcn_raw_buffer_store_b128(w, rO, rowoff + (unsigned)(d0 * 64 + k * 16), soff, 0); }
    }
}
template <bool NEEDMASK>
__device__ __forceinline__ void sb_tile(f32x16& p0, f32x16& p1, float& R, int dq, int hi) {
    float G[8];
#pragma unroll
    for (int half = 0; half < 2; ++half) {
        f32x16& p = half ? p1 : p0;
#pragma unroll
        for (int i = 0; i < 4; ++i) {
            float be[4], rc[4];
#pragma unroll
            for (int j = 0; j < 4; ++j) { const int c = j + 8 * i + 32 * half;
                const float e = __builtin_amdgcn_exp2f(p[4 * i + j]); rc[j] = __builtin_amdgcn_rcpf(1.0f + e); be[j] = 1.0f - rc[j];
                if (NEEDMASK) { const bool ok = c < dq; rc[j] = ok ? rc[j] : 1.0f; be[j] = ok ? be[j] : 0.0f; } }
            const float s2 = rc[3], s1 = s2 * rc[2], s0 = s1 * rc[1];
            G[4 * half + i] = s0 * rc[0];
            p[4 * i + 3] = be[3]; p[4 * i + 2] = be[2] * s2; p[4 * i + 1] = be[1] * s1; p[4 * i + 0] = be[0] * s0;
        }
    }
    float T[8], Pn[8];
#pragma unroll
    for (int g = 0; g < 8; ++g) { const U2 rr = swap_self(__builtin_bit_cast(unsigned, G[g]));
        const float lo = __builtin_bit_cast(float, rr.lo), up = __builtin_bit_cast(float, rr.up);
        T[g] = lo * up; Pn[g] = hi ? 1.0f : up; }
    float ST = 1.0f;
#pragma unroll
    for (int g = 7; g >= 0; --g) { const float A = R * ST * Pn[g]; f32x16& p = (g >> 2) ? p1 : p0; const int i = g & 3;
        p[4 * i + 0] *= A; p[4 * i + 1] *= A; p[4 * i + 2] *= A; p[4 * i + 3] *= A;
        ST *= T[g]; }
    R *= ST;
}

__device__ __forceinline__ bool R_any_alive(float R) { return __any(R != 0.0f) != 0; }
template <int MODE, bool STAGGER>
__device__ __forceinline__ void attn_phase(const Ctx& X, const bf16* QN, const bf16* KN, const bf16* VN, const unsigned* BITS, bf16* O) {
    const int tid = X.tid, wid = X.wave, lane = X.lane, r32 = lane & 31, hi = lane >> 5;
    LAS char* lds = (LAS char*)(X.lds + RING_OFF);
    const bool late = STAGGER && wid >= 4;
    LAS char* V_lds = lds; LAS char* K_lds = lds + 3 * SHM_V;
    volatile LAS unsigned* flags = (volatile LAS unsigned*)(lds + 3 * SHM_V + 2 * SHM_K);
    const int sr = tid >> 4, sc = (tid & 15) * 8, vst0 = v_st(sr, sc), vst1 = v_st(32 + sr, sc), kws = KSWZ(sr, sc * 2);
    const int vbase = (int)(uintptr_t)V_lds + v_rd_base(lane);
    const unsigned voff0 = (unsigned)(sr * D + sc) * 2u, voff1 = voff0 + 32u * D * 2u;
    const unsigned qoff = (unsigned)((wid * 32 + r32) * D + hi * 8) * 2u;
    const unsigned boff = (unsigned)(wid * 32 + r32) * 512u;
    const __amdgpu_buffer_rsrc_t rK = __builtin_amdgcn_make_buffer_rsrc((void*)KN, (short)0, M * D * 2, 0x00020000);
    const __amdgpu_buffer_rsrc_t rV = __builtin_amdgcn_make_buffer_rsrc((void*)VN, (short)0, M * D * 2, 0x00020000);
    const __amdgpu_buffer_rsrc_t rQ = __builtin_amdgcn_make_buffer_rsrc((void*)QN, (short)0, M * D * 2, 0x00020000);
    const __amdgpu_buffer_rsrc_t rO = __builtin_amdgcn_make_buffer_rsrc((void*)O, (short)0, M * D * 2, 0x00020000);
    const __amdgpu_buffer_rsrc_t rB = __builtin_amdgcn_make_buffer_rsrc((void*)(MODE == 1 ? (const void*)BITS : (const void*)QN), (short)0, M * 128 * 4, 0x00020000);
    for (int slot = X.vcu; slot < 256; slot += X.G) {
        const int bh = slot >> 2, sub = slot & 3, b = bh >> 4, h = bh & 15;
        const unsigned kvso = (unsigned)((b * S) * D + h * HD) * 2u;
        for (int qi = 0; qi < 4; ++qi) {
            const int qb = (qi == 0) ? sub : (qi == 1) ? 7 - sub : (qi == 2) ? 8 + sub : 15 - sub;
            const int P0 = qb * 256, NT = P0 / KVBLK + 4;
            const int qlo = P0 + wid * 32, qpos = qlo + r32;
            const unsigned qso = (unsigned)((b * S + P0) * D + h * HD) * 2u, bso = (unsigned)(b * S + P0) * 512u;
            bf16x8 qr[8];
#pragma unroll
            for (int d0 = 0; d0 < 8; ++d0) { const v4u q4 = __builtin_amdgcn_raw_buffer_load_b128(rQ, qoff + d0 * 32u, qso, 0); qr[d0] = __builtin_bit_cast(bf16x8, q4); }
            f32x16 o[4] = {};
            float R = 1.0f, m_reg = -1e30f, l_reg = 0.f;
            bf16x8 st_k0, st_k1, st_v0, st_v1;
#define ATT_KB(t) ((MODE == 0) ? (NT - 1 - (t)) * KVBLK : (t) * KVBLK)
#define ATT_LOAD(kb_) do { const unsigned so_ = kvso + (unsigned)(kb_) * (D * 2u); \
                           st_k0 = __builtin_bit_cast(bf16x8, __builtin_amdgcn_raw_buffer_load_b128(rK, voff0, so_, 0)); st_k1 = __builtin_bit_cast(bf16x8, __builtin_amdgcn_raw_buffer_load_b128(rK, voff1, so_, 0)); \
                           st_v0 = __builtin_bit_cast(bf16x8, __builtin_amdgcn_raw_buffer_load_b128(rV, voff0, so_, 0)); st_v1 = __builtin_bit_cast(bf16x8, __builtin_amdgcn_raw_buffer_load_b128(rV, voff1, so_, 0)); } while (0)
#define ATT_WRITE(kbf, vbf) do { *reinterpret_cast<LAS bf16x8*>(K_lds + (kbf) * SHM_K + kws) = st_k0; *reinterpret_cast<LAS bf16x8*>(K_lds + (kbf) * SHM_K + kws + 32 * 256) = st_k1; \
                           *reinterpret_cast<LAS bf16x8*>(V_lds + (vbf) * SHM_V + vst0) = st_v0; *reinterpret_cast<LAS bf16x8*>(V_lds + (vbf) * SHM_V + vst1) = st_v1; } while (0)
            __syncthreads();
            ATT_LOAD(ATT_KB(0)); ATT_WRITE(0, 0);
            bf16x8 pa0, pa1, pa2, pa3; bool pend = false; int vb = 0, vbp = 0;
            unsigned mw0 = 0u, mw1 = 0u;
            if (MODE == 1) { const v2u bw = __builtin_amdgcn_raw_buffer_load_b64(rB, boff, bso, 0); mw0 = bw.x; mw1 = bw.y; }
            __syncthreads();
            for (int t = 0; t < NT; ++t) {
                const int kb = ATT_KB(t), buf = t & 1;
                const bool more = t + 1 < NT;
                if (more) ATT_LOAD(ATT_KB(t + 1));
                unsigned nw0 = 0u, nw1 = 0u;
                if (MODE == 1 && more) { const v2u bw = __builtin_amdgcn_raw_buffer_load_b64(rB, boff, bso + (unsigned)((kb + KVBLK) >> 5) * 4u, 0); nw0 = bw.x; nw1 = bw.y; }
                if (late && pend) { pv_tile(o, vbase + vbp * SHM_V, pa0, pa1, pa2, pa3); pend = false; }
                const bool act = (MODE == 0) ? (kb < qlo + 31 && R_any_alive(R)) : (kb <= qlo + 31);
                if (act) {
                    f32x16 p0, p1;
                    qkt(p0, p1, K_lds + buf * SHM_K, r32, hi, qr);
                    if (MODE == 0) {
                        if (kb + KVBLK - 1 >= qlo) sb_tile<true>(p0, p1, R, qpos - kb - 4 * hi, hi); else sb_tile<false>(p0, p1, R, 0, hi);
                    } else {
                        const float NEG = -__builtin_inff();
                        const unsigned s0 = mw0 >> (4 * hi), s1 = mw1 >> (4 * hi);
#pragma unroll
                        for (int r = 0; r < 16; ++r) { const unsigned bit = 1u << ((r & 3) + 8 * (r >> 2)); p0[r] = (s0 & bit) ? p0[r] : NEG; p1[r] = (s1 & bit) ? p1[r] : NEG; }
                        float pmax = p0[0];
#pragma unroll
                        for (int r = 1; r < 16; ++r) pmax = fmaxf(pmax, p0[r]);
#pragma unroll
                        for (int r = 0; r < 16; ++r) pmax = fmaxf(pmax, p1[r]);
                        pmax = swap_max(pmax);
                        const float mn = fmaxf(m_reg, pmax), alpha = __builtin_amdgcn_exp2f(m_reg - mn); m_reg = mn;
                        float ps = 0.f;
#pragma unroll
                        for (int r = 0; r < 16; ++r) { p0[r] = __builtin_amdgcn_exp2f(p0[r] - mn); p1[r] = __builtin_amdgcn_exp2f(p1[r] - mn); ps += p0[r] + p1[r]; }
                        ps = swap_add(ps);
                        l_reg = l_reg * alpha + ps;
                        if (__any(alpha < 1.0f)) {
#pragma unroll
                            for (int d_ = 0; d_ < 4; ++d_) o[d_] *= alpha; }
                    }
                    ATT_PK4(p0, 0, pa0); ATT_PK4(p0, 8, pa1); ATT_PK4(p1, 0, pa2); ATT_PK4(p1, 8, pa3);
                    if (!late) pv_tile(o, vbase + vb * SHM_V, pa0, pa1, pa2, pa3); else { pend = true; vbp = vb; }
                }
                const int vbn = (vb == 2) ? 0 : vb + 1;
                if (more) ATT_WRITE(buf ^ 1, vbn);
                mw0 = nw0; mw1 = nw1;
                if (MODE == 0) { if (lane == 0) flags[buf * 8 + wid] = R_any_alive(R) ? 1u : 0u; }
                __syncthreads();
                if (MODE == 0) { unsigned alive = 0u;
#pragma unroll
                    for (int w = 0; w < 8; ++w) alive |= flags[buf * 8 + w];
                    if (alive == 0u) break; }
                vb = vbn;
            }
            if (late && pend) pv_tile(o, vbase + vbp * SHM_V, pa0, pa1, pa2, pa3);
            const unsigned oso = (unsigned)((b * S + qlo) * D + h * HD) * 2u;
            store_o_rows(o, (MODE == 1) ? __builtin_amdgcn_rcpf(l_reg) : 1.0f, rO, (unsigned)(r32 * D) * 2u + (unsigned)hi * 16u, oso);
#undef ATT_KB
#undef ATT_LOAD
#undef ATT_WRITE
        }
    }
}
__device__ __forceinline__ void dsa_mask(f32x16& p0, f32x16& p1, unsigned w0, unsigned w1, int hi) {
    typedef unsigned u32x16 __attribute__((ext_vector_type(16)));
    const unsigned NEGB = 0xff800000u; const int s0 = (int)(w0 >> (4 * hi)), s1 = (int)(w1 >> (4 * hi));
    u32x16 b0 = __builtin_bit_cast(u32x16, p0), b1 = __builtin_bit_cast(u32x16, p1);
#pragma unroll
    for (int r = 0; r < 16; ++r) { const int pos = (r & 3) + 8 * (r >> 2);
        const unsigned m0 = (unsigned)((s0 << (31 - pos)) >> 31), m1 = (unsigned)((s1 << (31 - pos)) >> 31);
        b0[r] = (b0[r] & m0) | (NEGB & ~m0); b1[r] = (b1[r] & m1) | (NEGB & ~m1); }
    p0 = __builtin_bit_cast(f32x16, b0); p1 = __builtin_bit_cast(f32x16, b1);
}
__device__ __forceinline__ void dsa_partial(f32x16& p0, f32x16& p1, float& m_reg, float& mn, float& alpha) {
    float pmax = p0[0];
#pragma unroll
    for (int r = 1; r < 16; ++r) pmax = fmaxf(pmax, p0[r]);
#pragma unroll
    for (int r = 0; r < 16; ++r) pmax = fmaxf(pmax, p1[r]);
    pmax = swap_max(pmax);
    if (__all(pmax - m_reg <= 8.0f)) { mn = m_reg; alpha = 1.0f; }
    else { mn = fmaxf(m_reg, pmax); alpha = __builtin_amdgcn_exp2f(m_reg - mn); m_reg = mn; }
#pragma unroll
    for (int r = 0; r < 16; ++r) p0[r] = __builtin_amdgcn_exp2f(p0[r] - mn);
}
__device__ __forceinline__ void dsa_finish(f32x16& p0, f32x16& p1, float mn, float alpha, float& l_reg, bf16x8& pa0, bf16x8& pa1, bf16x8& pa2, bf16x8& pa3) {
#pragma unroll
    for (int r = 0; r < 16; ++r) p1[r] = __builtin_amdgcn_exp2f(p1[r] - mn);
    float ps = 0.f;
#pragma unroll
    for (int r = 0; r < 16; ++r) ps += p0[r];
#pragma unroll
    for (int r = 0; r < 16; ++r) ps += p1[r];
    ps = swap_add(ps);
    l_reg = l_reg * alpha + ps;
    ATT_PK4(p0, 0, pa0); ATT_PK4(p0, 8, pa1); ATT_PK4(p1, 0, pa2); ATT_PK4(p1, 8, pa3);
}
__device__ __forceinline__ void attn_dsa_pipelined(const Ctx& X, const bf16* QN, const bf16* KN, const bf16* VN, const unsigned* BITS, bf16* O) {
    const int tid = X.tid, wid = X.wave, lane = X.lane, r32 = lane & 31, hi = lane >> 5;
    LAS char* lds = (LAS char*)(X.lds + RING_OFF);
    LAS char* V_lds = lds + OFF_V; LAS char* K_lds = lds + OFF_K;
    LAS float* wsl = (LAS float*)(lds + OFF_WS) + wid * 64;
    const int sr = tid >> 4, sc = (tid & 15) * 8, vst0 = v_st(sr, sc), vst1 = v_st(32 + sr, sc), kws = KSWZ(sr, sc * 2);
    const int vbase = (int)(uintptr_t)V_lds + v_rd_base(lane);
    const unsigned voff0 = (unsigned)(sr * D + sc) * 2u, voff1 = voff0 + 32u * D * 2u;
    const unsigned qoff = (unsigned)((wid * 32 + r32) * D + hi * 8) * 2u;
    const unsigned boff = (unsigned)(wid * 32 + r32) * 512u;
    const __amdgpu_buffer_rsrc_t rK = __builtin_amdgcn_make_buffer_rsrc((void*)KN, (short)0, M * D * 2, 0x00020000);
    const __amdgpu_buffer_rsrc_t rV = __builtin_amdgcn_make_buffer_rsrc((void*)VN, (short)0, M * D * 2, 0x00020000);
    const __amdgpu_buffer_rsrc_t rQ = __builtin_amdgcn_make_buffer_rsrc((void*)QN, (short)0, M * D * 2, 0x00020000);
    const __amdgpu_buffer_rsrc_t rO = __builtin_amdgcn_make_buffer_rsrc((void*)O, (short)0, M * D * 2, 0x00020000);
    const __amdgpu_buffer_rsrc_t rB = __builtin_amdgcn_make_buffer_rsrc((void*)BITS, (short)0, M * 128 * 4, 0x00020000);
    for (int slot = X.vcu; slot < 256; slot += X.G) {
        const int bh = slot >> 2, sub = slot & 3, b = bh >> 4, h = bh & 15;
        const unsigned kvso = (unsigned)((b * S) * D + h * HD) * 2u;
        for (int qi = 0; qi < 4; ++qi) {
            const int qb = (qi == 0) ? sub : (qi == 1) ? 7 - sub : (qi == 2) ? 8 + sub : 15 - sub;
            const int P0 = qb * 256, NT = P0 / KVBLK + 4;
            const int qlo = P0 + wid * 32;
            const unsigned qso = (unsigned)((b * S + P0) * D + h * HD) * 2u, bso = (unsigned)(b * S + P0) * 512u;
            bf16x8 qr[8];
#pragma unroll
            for (int d0 = 0; d0 < 8; ++d0) { const v4u q4 = __builtin_amdgcn_raw_buffer_load_b128(rQ, qoff + d0 * 32u, qso, 0); qr[d0] = __builtin_bit_cast(bf16x8, q4); }
            f32x16 o[4] = {};
            float m_reg = -1e30f, l_reg = 0.f;
            bf16x8 st_k0, st_k1, st_v0, st_v1; v2u mwn = {0u, 0u};
#define DSA_LOAD(t_) do { const unsigned so_ = kvso + (unsigned)((t_) * KVBLK) * (D * 2u); \
                          st_k0 = __builtin_bit_cast(bf16x8, __builtin_amdgcn_raw_buffer_load_b128(rK, voff0, so_, 0)); st_k1 = __builtin_bit_cast(bf16x8, __builtin_amdgcn_raw_buffer_load_b128(rK, voff1, so_, 0)); \
                          st_v0 = __builtin_bit_cast(bf16x8, __builtin_amdgcn_raw_buffer_load_b128(rV, voff0, so_, 0)); st_v1 = __builtin_bit_cast(bf16x8, __builtin_amdgcn_raw_buffer_load_b128(rV, voff1, so_, 0)); \
                          mwn = __builtin_amdgcn_raw_buffer_load_b64(rB, boff, bso + (unsigned)(t_) * 8u, 0); } while (0)
#define DSA_WRITE(bf) do { *reinterpret_cast<LAS bf16x8*>(K_lds + (bf) * SHM_K + kws) = st_k0; *reinterpret_cast<LAS bf16x8*>(K_lds + (bf) * SHM_K + kws + 32 * 256) = st_k1; \
                           *reinterpret_cast<LAS bf16x8*>(V_lds + (bf) * SHM_V + vst0) = st_v0; *reinterpret_cast<LAS bf16x8*>(V_lds + (bf) * SHM_V + vst1) = st_v1; } while (0)
#define DSA_ACT(t_) ((t_) * KVBLK <= qlo + 31)
#define DSA_RESC(a) do { if (__any((a) < 1.0f)) { _Pragma("unroll") for (int d_ = 0; d_ < 4; ++d_) o[d_] *= (a); } } while (0)
            f32x16 pA0, pA1, pB0, pB1; float mnA = 0.f, mnB = 0.f, alA = 1.f, alB = 1.f; bf16x8 pa0, pa1, pa2, pa3; unsigned mw0, mw1;
            __syncthreads();
            DSA_LOAD(0); DSA_WRITE(0); mw0 = mwn.x; mw1 = mwn.y;
            DSA_LOAD(1);
            __syncthreads();
            qkt(pA0, pA1, K_lds, r32, hi, qr);
            DSA_WRITE(1);
            dsa_mask(pA0, pA1, mw0, mw1, hi); dsa_partial(pA0, pA1, m_reg, mnA, alA);
            mw0 = mwn.x; mw1 = mwn.y;
            __syncthreads();
#define DSA_HALF(PX0, PX1, mnX, alX, PY0, PY1, mnY, alY, t_, KB, VB, SB_) do { \
                const bool actx = DSA_ACT(t_), acty = DSA_ACT((t_) - 1); \
                if (actx) qkt(PX0, PX1, K_lds + (KB) * SHM_K, r32, hi, qr); \
                if (acty) dsa_finish(PY0, PY1, mnY, alY, l_reg, pa0, pa1, pa2, pa3); \
                if ((t_) + 1 < NT) DSA_LOAD((t_) + 1); \
                if (acty) pv_tile(o, vbase + (VB) * SHM_V, pa0, pa1, pa2, pa3); \
                if (actx) { dsa_mask(PX0, PX1, mw0, mw1, hi); dsa_partial(PX0, PX1, m_reg, mnX, alX); } else { alX = 1.0f; } \
                mw0 = mwn.x; mw1 = mwn.y; \
                __syncthreads(); \
                if ((t_) + 1 < NT) DSA_WRITE(SB_); \
                if (actx) DSA_RESC(alX); \
                __syncthreads(); } while (0)
            for (int t = 1; t + 1 < NT; t += 2) {
                DSA_HALF(pB0, pB1, mnB, alB, pA0, pA1, mnA, alA, t, 1, 0, 0);
                DSA_HALF(pA0, pA1, mnA, alA, pB0, pB1, mnB, alB, t + 1, 0, 1, 1);
            }
            { const bool actx = DSA_ACT(NT - 1), acty = DSA_ACT(NT - 2);
              if (actx) qkt(pB0, pB1, K_lds + SHM_K, r32, hi, qr);
              if (acty) { dsa_finish(pA0, pA1, mnA, alA, l_reg, pa0, pa1, pa2, pa3); pv_tile(o, vbase, pa0, pa1, pa2, pa3); }
              if (actx) { dsa_mask(pB0, pB1, mw0, mw1, hi); dsa_partial(pB0, pB1, m_reg, mnB, alB); DSA_RESC(alB);
                          dsa_finish(pB0, pB1, mnB, alB, l_reg, pa0, pa1, pa2, pa3); pv_tile(o, vbase + SHM_V, pa0, pa1, pa2, pa3); } }
            const unsigned oso = (unsigned)((b * S + qlo) * D + h * HD) * 2u;
            store_o_rows(o, __builtin_amdgcn_rcpf(l_reg), rO, (unsigned)(r32 * D) * 2u + (unsigned)hi * 16u, oso);
#undef DSA_LOAD
#undef DSA_WRITE
#undef DSA_ACT
#undef DSA_RESC
#undef DSA_HALF
        }
    }
}
}
struct Args { const void* in[27]; float* out; unsigned char* ws; };
typedef const void* cvp_t;
__device__ __forceinline__ const void* karg(int i) {
    unsigned long long a = (unsigned long long)__builtin_amdgcn_kernarg_segment_ptr(); asm volatile("" : "+s"(a));
    return ((const __attribute__((address_space(4))) cvp_t*)a)[i];
}
enum { I_X = 0, I_C, I_POS, I_LN1G, I_LN2G, I_ADAW, I_ADAB, I_W1, I_W2, I_SBWIN, I_SBQG, I_SBKG, I_SBWOUT, I_S5WIN, I_S5LRE, I_S5LIM, I_S5LOGDT, I_S5BRE, I_S5BIM,
       I_S5CRE, I_S5CIM, I_S5D, I_S5WGLU, I_DSAWIN, I_DSAQG, I_DSAKG, I_DSAWOUT };

__global__ void __launch_bounds__(NWAVES * 64, 2) fwd_kernel(Args args) {
    extern __shared__ __attribute__((aligned(16))) unsigned char lds_raw[];
    Ctx X;
    X.lds = (LAS unsigned char*)lds_raw;
    X.tid = threadIdx.x; X.lane = X.tid & 63; X.wave = __builtin_amdgcn_readfirstlane(X.tid >> 6);
    X.G = gridDim.x; { const int bx = blockIdx.x; X.vcu = (X.G % 8 == 0) ? (bx % 8) * (X.G / 8) + bx / 8 : bx; }
    X.gw = X.vcu * NWAVES + X.wave; X.NGW = X.G * NWAVES;
    unsigned* ctl = (unsigned*)(args.ws + WS_CTL);
    for (int u = X.tid; u < (LDS_BYTES - LDSCTL_OFF) / 4; u += NWAVES * 64) ((LAS unsigned*)(X.lds + LDSCTL_OFF))[u] = 0u;
    __syncthreads();
    volatile LAS unsigned* MISC = (volatile LAS unsigned*)(X.lds + MISC_OFF);
    XcdBarrier bar = xcd_barrier_post(ctl + CW_BAR, MISC + 8);
#define GRID_BAR() do { XcdBarrier bb_ = bar; asm volatile("" : "+s"(bb_.x), "+s"(bb_.bar)); const Ctx xb_ = fresh(X); xcd_barrier(bb_, xb_.tid == 0); } while (0)

#define INF(i) ((const float*)karg(i))
#define WSP(T, off) ((T*)((unsigned char*)karg(28) + (off)))
#define XOUT ((float*)karg(27))
#define MOD WSP(float, WS_MOD)
#define S5C WSP(float, WS_S5C)
#define W1T WSP(bf16, WS_W1T)
#define W2T WSP(bf16, WS_W2T)
#define SBIN WSP(bf16, WS_SBIN)
#define SBOUT WSP(bf16, WS_SBOUT)
#define S5IN WSP(bf16, WS_S5IN)
#define S5GLU WSP(bf16, WS_S5GLU)
#define DSAIN WSP(bf16, WS_DSAIN)
#define DSAOUT WSP(bf16, WS_DSAOUT)
#define H WSP(bf16, WS_H)
#define BIG WSP(float, WS_BIG)
#define QN WSP(bf16, WS_QN)
#define KN WSP(bf16, WS_KN)
#define VN WSP(bf16, WS_VN)
#define OB WSP(bf16, WS_O)
#define QI WSP(bf16, WS_QI)
#define KI WSP(bf16, WS_KI)
#define WI WSP(float, WS_WI)
#define BITS WSP(unsigned, WS_BITS)
#define E5 WSP(float, WS_E)
#define AG WSP(bf16, WS_AG)
#define XH WSP(_Float16, WS_XH)
#define B1S WSP(bf16, WS_B1)
#define B3S WSP(bf16, WS_B3)
    LAS unsigned char* ring = X.lds + RING_OFF;

    _Pragma("unroll 1") for (int rpro_ = 0; rpro_ < REP_PRO; ++rpro_) {
    _Pragma("unroll 1") for (int rep_ = 0; rep_ < REP_MOD; ++rep_) ph_mod(fresh(X), INF(I_C), INF(I_ADAW), INF(I_ADAB), MOD);
    _Pragma("unroll 1") for (int rep_ = 0; rep_ < REP_S5PRE; ++rep_)
    ph_s5_pre(fresh(X), INF(I_S5LRE), INF(I_S5LIM), INF(I_S5LOGDT), INF(I_S5BRE), INF(I_S5BIM), INF(I_S5CRE), INF(I_S5CIM), S5C, B1S, B3S);
    int trot = 0;
    _Pragma("unroll 1") for (int rep_ = 0; rep_ < REP_TR; ++rep_) {
    for (int l = 0; l < NL - 1; ++l) {
        if (l != 2) { const Ctx Y = fresh(X); tr_matrix(Y, INF(I_W1) + (size_t)l * D * FF, D, FF, FF, W1T + (size_t)l * FF * D, 0, trot, Y.gw, Y.NGW); }
        { const Ctx Y = fresh(X); tr_matrix(Y, INF(I_W2) + (size_t)l * FF * D, FF, D, D, W2T + (size_t)l * D * FF, 0, trot, Y.gw, Y.NGW); }
    }
    for (int j = 0; j < 2; ++j) {
        { const Ctx Y = fresh(X); tr_matrix(Y, INF(I_SBWIN) + (size_t)j * D * 3 * D, D, 3 * D, 3 * D, SBIN + (size_t)j * 3 * D * D, TR_QKV, trot, Y.gw, Y.NGW); }
        { const Ctx Y = fresh(X); tr_matrix(Y, INF(I_SBWOUT) + (size_t)j * D * D, D, D, D, SBOUT + (size_t)j * D * D, 0, trot, Y.gw, Y.NGW); }
    }
    { const Ctx Y = fresh(X); tr_matrix(Y, INF(I_S5WIN), D, D, D, S5IN, 0, trot, Y.gw, Y.NGW); }
    { const Ctx Y = fresh(X); tr_matrix(Y, INF(I_S5WGLU), D, 2 * D, 2 * D, S5GLU, TR_GLU, trot, Y.gw, Y.NGW); }
    { const Ctx Y = fresh(X); tr_matrix(Y, INF(I_DSAWIN), D, DSA_N, DSA_NP, DSAIN, TR_DSA, trot, Y.gw, Y.NGW); }
    ph_rope_tables(fresh(X), (const int*)karg(I_POS), WSP(float, WS_CS), WSP(float, WS_CS2));
    { const Ctx Y = fresh(X); tr_matrix(Y, INF(I_DSAWOUT), D, D, D, DSAOUT, 0, trot, Y.gw, Y.NGW); }
    }
    GRID_BAR();
    }

#define XCUR ((l == 0) ? INF(I_X) : (const float*)XOUT)
    for (int l = 0; l < NL; ++l) {
        const int kind = l % 3, jm = l / 3;
        _Pragma("unroll 1") for (int rep_ = 0; rep_ < REP_LN; ++rep_) { if (l == 0) ph_ln_mod(fresh(X), INF(I_X), INF(I_LN1G) + (size_t)l * D, (MOD + (size_t)l * NB * 6 * D), 0, D, H); else ph_ln_mod_h(fresh(X), XH, INF(I_LN1G) + (size_t)l * D, (MOD + (size_t)l * NB * 6 * D), 0, D, H); GRID_BAR(); }
        if (kind == 1) {
            pg8::Gemm g{H, S5IN, M, D, D}; pg8::StaticOrder So; So.init(M, D, X.G, (int)blockIdx.x, WGM_S5U);
            pg8::EpiS5U Ep{AG};
            _Pragma("unroll 1") for (int rep_ = 0; rep_ < REP_S5U; ++rep_) {
            pg8::gemm_phase<pg8::EpiS5U, pg8::StaticOrder, true, true>(ring, g, So, Ep, X.wave);
            GRID_BAR(); }
        } else {
            const bf16* Bt = kind == 0 ? SBIN + (size_t)jm * 3 * D * D : DSAIN;
            const int N = kind == 0 ? 3 * D : DSA_NP;
            pg8::Gemm g{H, Bt, M, N, D}; pg8::StaticOrder So; So.init(M, N, X.G, (int)blockIdx.x, WGM_QKV);
            pg8::EpiQkv Ep{QN, KN, VN, QI, KI, WI, kind == 0 ? INF(I_SBQG) + jm * HD : INF(I_DSAQG), kind == 0 ? INF(I_SBKG) + jm * HD : INF(I_DSAKG), WSP(float, WS_CS), WSP(float, WS_CS2), kind == 2 ? 1 : 0, QSCALE, EPS,
                           (PG8_LAS float*)(X.lds + EPI_OFF)};
            _Pragma("unroll 1") for (int rep_ = 0; rep_ < REP_QKV; ++rep_) {
            Ep.skip = (EPI_NULL && rep_ < REP_QKV - 1) ? 1 : 0;
            pg8::gemm_phase<pg8::EpiQkv, pg8::StaticOrder, true, true>(ring, g, So, Ep, X.wave);
            if (l == 2) {
                const int nun = (M / 256) * (DSA_NP / 256), rounds = (nun + X.G - 1) / X.G; int fi = nun - (rounds - 1) * X.G; if (fi >= X.G) fi = 0;
                if ((int)blockIdx.x >= fi) { int drot = 0; const Ctx Y = fresh(X); const int dgw = ((int)blockIdx.x - fi) * NWAVES + Y.wave, dn = (Y.G - fi) * NWAVES;
                    tr_matrix(Y, INF(I_W1) + (size_t)3 * D * FF, D, FF, FF, W1T + (size_t)3 * FF * D, 0, drot, dgw, dn);
                    tr_matrix(Y, INF(I_W2) + (size_t)3 * FF * D, FF, D, D, W2T + (size_t)3 * D * FF, 0, drot, dgw, dn);
                }
            }
            GRID_BAR(); }
        }
        if (kind == 0) {
            _Pragma("unroll 1") for (int rep_ = 0; rep_ < REP_ATT_SB; ++rep_) { att::attn_phase<0, SB_STAG>(fresh(X), QN, KN, VN, nullptr, OB); GRID_BAR(); }
        } else if (kind == 1) {
            { pg8::Gemm g{AG, B1S, G5 * 1024, 256, 256, 384, 256}; pg8::GroupOrder So{X.G, (int)blockIdx.x};
              pg8::EpiS5E Ep{E5};
              _Pragma("unroll 1") for (int rep_ = 0; rep_ < REP_S5A; ++rep_) {
              pg8::gemm_phase<pg8::EpiS5E, pg8::GroupOrder, true, true>(ring, g, So, Ep, X.wave); if (rep_ < REP_S5A - 1) GRID_BAR(); } }
            GRID_BAR();
            _Pragma("unroll 1") for (int rep_ = 0; rep_ < REP_CARRY; ++rep_) { ph_s5_carry(fresh(X), S5C, E5, AG);
            {
                const Ctx Y = fresh(X); const int busy = (G5 * NB + NWAVES - 1) / NWAVES, fi = busy < Y.G ? busy : 0;
                if (Y.vcu >= fi) { int drot = 0; tr_matrix(Y, INF(I_W1) + (size_t)2 * D * FF, D, FF, FF, W1T + (size_t)2 * FF * D, 0, drot, (Y.vcu - fi) * NWAVES + Y.wave, (Y.G - fi) * NWAVES); }
            }
            GRID_BAR(); }
            { pg8::Gemm g{AG, B3S, G5 * 1024, 256, 384, 384, 384}; pg8::GroupOrder So{X.G, (int)blockIdx.x};
              pg8::EpiS5Out Ep{__builtin_amdgcn_make_buffer_rsrc((void*)AG, (short)0, G5 * 1024 * 384 * 2, 0x00020000), __builtin_amdgcn_make_buffer_rsrc((void*)OB, (short)0, M * D * 2, 0x00020000), __builtin_amdgcn_make_buffer_rsrc((void*)INF(I_S5D), (short)0, D * 4, 0x00020000)};
              _Pragma("unroll 1") for (int rep_ = 0; rep_ < REP_S5B; ++rep_) {
              pg8::gemm_phase<pg8::EpiS5Out, pg8::GroupOrder, true, true>(ring, g, So, Ep, X.wave); if (rep_ < REP_S5B - 1) GRID_BAR(); } }
            GRID_BAR();
        } else {
            _Pragma("unroll 1") for (int rep_ = 0; rep_ < REP_IDX; ++rep_) { ph_idx_scores(fresh(X), QI, KI, WI, BIG, BITS); GRID_BAR(); }
            _Pragma("unroll 1") for (int rep_ = 0; rep_ < REP_ATT_DSA; ++rep_) {
#if DSA_VARIANT == 0
            att::attn_dsa_pipelined(fresh(X), QN, KN, VN, BITS, OB);
#elif DSA_VARIANT == 1
            att::attn_phase<1, true>(fresh(X), QN, KN, VN, BITS, OB);
#else
            att::attn_phase<1, false>(fresh(X), QN, KN, VN, BITS, OB);
#endif
            GRID_BAR(); }
        }
        if (kind == 1) {
            pg8::Gemm g{OB, S5GLU, M, 2 * D, D, 0, 0}; pg8::StaticOrder So; So.init(M, 2 * D, X.G, (int)blockIdx.x, WGM_GLU);
            _Pragma("unroll 1") for (int rep_ = 0; rep_ < REP_OUT; ++rep_) {
            pg8::EpiGluRes Ep{XH, rep_ == REP_OUT - 1 ? XH : WSP(_Float16, WS_QN), (MOD + (size_t)l * NB * 6 * D) + 2 * D, 6 * D};
            pg8::gemm_phase<pg8::EpiGluRes, pg8::StaticOrder, true, true, true>(ring, g, So, Ep, X.wave); if (rep_ < REP_OUT - 1) GRID_BAR(); }
        } else {
            const bf16* Bt = kind == 0 ? SBOUT + (size_t)jm * D * D : DSAOUT;
            pg8::Gemm g{OB, Bt, M, D, D}; pg8::StaticOrder So; So.init(M, D, X.G, (int)blockIdx.x, WGM_OUT);
            _Pragma("unroll 1") for (int rep_ = 0; rep_ < REP_OUT; ++rep_) {
            pg8::EpiRes Ep{l == 0 ? (const void*)INF(I_X) : (const void*)XH, rep_ == REP_OUT - 1 ? (void*)XH : (void*)WSP(_Float16, WS_QN), (MOD + (size_t)l * NB * 6 * D) + 2 * D, 6 * D, l == 0 ? 1 : 0, 0};
            pg8::gemm_phase<pg8::EpiRes, pg8::StaticOrder, true, true>(ring, g, So, Ep, X.wave); if (rep_ < REP_OUT - 1) GRID_BAR(); }
        }
        GRID_BAR();
        _Pragma("unroll 1") for (int rep_ = 0; rep_ < REP_LN; ++rep_) { ph_ln_mod_h(fresh(X), XH, INF(I_LN2G) + (size_t)l * D, (MOD + (size_t)l * NB * 6 * D), 3 * D, 4 * D, H); GRID_BAR(); }
        _Pragma("unroll 1") for (int rep_ = 0; rep_ < REP_MLP; ++rep_) {
#define XDST(fin) ((fin) ? (l == NL - 1 ? (void*)(XOUT + r0 * D) : (void*)(XH + r0 * D)) : (l == NL - 1 ? (void*)(WSP(float, WS_QN) + r0 * D) : (void*)(WSP(_Float16, WS_QN) + r0 * D)))
#if MLP_VARIANT >= 1
        _Pragma("unroll 1") for (int st = 0; st < 3; ++st) {
            const int first_up = (MLP_VARIANT == 2 && st == 1) ? ((int)blockIdx.x & 1) : (MLP_VARIANT == 3 && st == 1) ? 1 : 0;
            _Pragma("unroll 1") for (int sub = 0; sub < 2; ++sub) {
            if ((sub ^ first_up) == 0) { if (st > 0) {
                const int hf = st - 1; const size_t r0 = (size_t)hf * (M / 2);
                pg8::Gemm g{(const bf16*)BIG + (size_t)hf * (M / 2) * FF, W2T + (size_t)l * D * FF, M / 2, D, FF}; pg8::StaticOrder So; So.init(M / 2, D, X.G, (int)blockIdx.x, WGM_W2);
                pg8::EpiRes Ep{XH + r0 * D, XDST(rep_ == REP_MLP - 1), (MOD + (size_t)l * NB * 6 * D) + 5 * D + (size_t)hf * 2 * 6 * D, 6 * D, 0, l == NL - 1 ? 1 : 0};
                pg8::gemm_phase<pg8::EpiRes, pg8::StaticOrder, true, true>(ring, g, So, Ep, X.wave);
            } } else { if (st < 2) {
                const int hf = st; const size_t r0 = (size_t)hf * (M / 2);
                pg8::Gemm g{H + r0 * D, W1T + (size_t)l * FF * D, M / 2, FF, D}; pg8::StaticOrder So; So.init(M / 2, FF, X.G, (int)blockIdx.x, WGM_W1);
                pg8::EpiRelu2 Ep{(bf16*)BIG + (size_t)hf * (M / 2) * FF, FF};
                pg8::gemm_phase<pg8::EpiRelu2, pg8::StaticOrder, true, true>(ring, g, So, Ep, X.wave);
            } }
            if (sub == 0 && st == 1) { VM_WAIT(); __syncthreads(); }
            }
            if (l + 1 < NL || st < 2 || rep_ < REP_MLP - 1) GRID_BAR();
        }
#else
        _Pragma("unroll 1") for (int hf = 0; hf < 2; ++hf) {
            const size_t r0 = (size_t)hf * (M / 2);
            {
                pg8::Gemm g{H + r0 * D, W1T + (size_t)l * FF * D, M / 2, FF, D}; pg8::StaticOrder So; So.init(M / 2, FF, X.G, (int)blockIdx.x, WGM_W1);
                pg8::EpiRelu2 Ep{(bf16*)BIG, FF};
                _Pragma("unroll 1") for (int r2_ = 0; r2_ < REP_W1; ++r2_) {
                Ep.skip = (EPI_NULL && r2_ < REP_W1 - 1) ? 1 : 0;
                pg8::gemm_phase<pg8::EpiRelu2, pg8::StaticOrder, true, true>(ring, g, So, Ep, X.wave);
                GRID_BAR(); }
            }
            {
                pg8::Gemm g{(const bf16*)BIG, W2T + (size_t)l * D * FF, M / 2, D, FF}; pg8::StaticOrder So; So.init(M / 2, D, X.G, (int)blockIdx.x, WGM_W2);
                _Pragma("unroll 1") for (int r2_ = 0; r2_ < REP_W2; ++r2_) {
                pg8::EpiRes Ep{XH + r0 * D, XDST(rep_ == REP_MLP - 1 && r2_ == REP_W2 - 1), (MOD + (size_t)l * NB * 6 * D) + 5 * D + (size_t)hf * 2 * 6 * D, 6 * D, 0, l == NL - 1 ? 1 : 0};
                pg8::gemm_phase<pg8::EpiRes, pg8::StaticOrder, true, true>(ring, g, So, Ep, X.wave);
                if (l + 1 < NL || hf == 0 || rep_ < REP_MLP - 1 || r2_ < REP_W2 - 1) GRID_BAR(); }
            }
        }
#endif
        }
    }
    if (__hip_atomic_load(ctl + CW_BAR + XB_TMO, __ATOMIC_RELAXED, __HIP_MEMORY_SCOPE_AGENT) != 0u) {
        VM_WAIT(); __syncthreads();
        const float q = __builtin_nanf(""); const Ctx Xe = fresh(X);
        for (size_t i = (size_t)blockIdx.x * 512 + Xe.tid; i < (size_t)M * D; i += (size_t)X.G * 512) XOUT[i] = q;
    }
#undef GRID_BAR
}

extern "C" void kernel_launch(void* const* d_in, const int* in_sizes, int n_in, void* d_out, int out_size, void* d_ws, size_t ws_size, hipStream_t stream) {
    static int grid = 0;
    if (grid == 0) {
        if (n_in != 27 || in_sizes[0] != M * D || out_size != M * D || ws_size < WS_END) {
            fprintf(stderr, "kernel_launch: built for 27 inputs, x/out of %d floats, >= %zu bytes of workspace; got n_in %d, in0 %d, out %d, ws %zu; nothing launched\n", M * D, (size_t)WS_END, n_in, n_in > 0 ? in_sizes[0] : -1, out_size, ws_size);
            grid = -1; return; }
        int dev = 0, cus = 0, per_cu = 0;
        if (hipGetDevice(&dev) != hipSuccess || hipDeviceGetAttribute(&cus, hipDeviceAttributeMultiprocessorCount, dev) != hipSuccess) { fprintf(stderr, "kernel_launch: device query failed\n"); grid = -1; return; }
        if (hipFuncSetAttribute((const void*)fwd_kernel, hipFuncAttributeMaxDynamicSharedMemorySize, LDS_BYTES) != hipSuccess) { fprintf(stderr, "kernel_launch: hipFuncSetAttribute failed\n"); grid = -1; return; }
        if (hipOccupancyMaxActiveBlocksPerMultiprocessor(&per_cu, (const void*)fwd_kernel, NWAVES * 64, LDS_BYTES) != hipSuccess || per_cu < 1) {
            fprintf(stderr, "kernel_launch: occupancy query reports %d workgroups per CU for %d B of LDS; nothing launched\n", per_cu, LDS_BYTES); (void)hipGetLastError(); grid = -1; return; }
        grid = cus;
    }
    if (grid < 0) return;
    if (hipMemsetAsync((char*)d_ws + WS_CTL, 0, CTL_ZERO_BYTES, stream) != hipSuccess) { fprintf(stderr, "kernel_launch: memset failed\n"); return; }
    Args a{};
    for (int i = 0; i < 27; ++i) a.in[i] = d_in[i];
    a.out = (float*)d_out; a.ws = (unsigned char*)d_ws;
    hipLaunchKernelGGL(fwd_kernel, dim3(grid), dim3(NWAVES * 64), LDS_BYTES, stream, a);
    const hipError_t le = hipPeekAtLastError();
    if (le != hipSuccess) fprintf(stderr, "kernel_launch: launch failed: %s (grid %d)\n", hipGetErrorName(le), grid);
}
```
